# Optimizing an MI355X kernel written in HIP

```python
import jax, jax.numpy as jnp
from jax import lax
import numpy as np

D_MODEL = 2048
BATCH = 1
SEQ = 16384
DEPTH = 2

BRANCH_WIDTH = 512
N_BRANCHES = 4
GROUP_WIDTH = 128
N_GROUPS = BRANCH_WIDTH // GROUP_WIDTH
CONV_KERNEL = 31
POOL_WINDOWS = (2, 4, 8, 16)
SGU_CHUNK = 128
SHORT_CONV_KERNEL = 3
D_FF = 5632
N_SUBLAYERS = 3
N_MOD = 3
RMS_EPS = 1e-6
LN_EPS = 1e-5
MIX_SPLITS = (2 * BRANCH_WIDTH, 3 * BRANCH_WIDTH, 5 * BRANCH_WIDTH)
MIX_IN_WIDTH = 8 * BRANCH_WIDTH

kernel_name = "hybrid_gated_conv_pool_sgu_block"


def rms_norm(x, g):
    x32 = x.astype(jnp.float32)
    y = x32 * lax.rsqrt(jnp.mean(x32 * x32, axis=-1, keepdims=True) + RMS_EPS)
    return (y * g.astype(jnp.float32)).astype(x.dtype)


def layer_norm(x, g, b):
    x32 = x.astype(jnp.float32)
    mu = jnp.mean(x32, axis=-1, keepdims=True)
    xc = x32 - mu
    y = xc * lax.rsqrt(jnp.mean(xc * xc, axis=-1, keepdims=True) + LN_EPS)
    return (y * g.astype(jnp.float32) + b.astype(jnp.float32)).astype(x.dtype)


def modulate(n, shift, scale):
    return n * (1 + scale[:, None, :]) + shift[:, None, :]


def causal_depthwise_conv(x, w):
    k = w.shape[0]
    return lax.conv_general_dilated(
        x, w[:, None, :].astype(x.dtype), window_strides=(1,), padding=[(k - 1, 0)],
        dimension_numbers=("NWC", "WIO", "NWC"), feature_group_count=x.shape[-1])


def swiglu_ffn(n, w_in, w_out):
    gate, up = jnp.split(n @ w_in, 2, axis=-1)
    return (jax.nn.silu(gate) * up) @ w_out


def conformer_conv_mixer(p, conv_w, conv_b, ln_g, ln_b):
    val, gate = jnp.split(p, 2, axis=-1)
    a = val * jax.nn.sigmoid(gate)
    a = causal_depthwise_conv(a, conv_w) + conv_b
    return jax.nn.silu(layer_norm(a, ln_g, ln_b))


def multiscale_pool_mixer(p, group_w, scale):
    b, s, _ = p.shape
    xg = p.reshape(b, s, N_GROUPS, GROUP_WIDTH).astype(jnp.float32)
    pos1 = jnp.arange(1, s + 1, dtype=jnp.int32)
    outs = []
    for gi, win in enumerate(POOL_WINDOWS):
        seg = xg[:, :, gi]
        cs = jnp.cumsum(seg, axis=1)
        lag = jnp.pad(cs, ((0, 0), (win, 0), (0, 0)))[:, :s]
        cnt = jnp.minimum(pos1, win).astype(jnp.float32)[None, :, None]
        outs.append((cs - lag) / cnt - seg)
    pooled = jnp.stack(outs, axis=2).astype(p.dtype)
    mixed = jnp.einsum("bsgc,gcd->bsgd", pooled, group_w)
    return mixed.reshape(b, s, BRANCH_WIDTH) * scale


def spatial_gating_mixer(p, ln_g, ln_b, w_s, b_s):
    b, s, _ = p.shape
    u, v = jnp.split(jax.nn.gelu(p, approximate=False), 2, axis=-1)
    v = layer_norm(v, ln_g, ln_b).reshape(b, s // SGU_CHUNK, SGU_CHUNK, N_GROUPS, GROUP_WIDTH)
    mask = jnp.tril(jnp.ones((SGU_CHUNK, SGU_CHUNK), dtype=bool))
    w_causal = jnp.where(mask[None], w_s, 0)
    sv = jnp.einsum("gtj,bnjgc->bntgc", w_causal, v) + b_s.T[None, None, :, :, None]
    return u * sv.reshape(b, s, BRANCH_WIDTH)


def short_conv_mixer(p, conv_w):
    gb, gc, h = jnp.split(p, 3, axis=-1)
    return gb * causal_depthwise_conv(gc * h, conv_w)


def setup_inputs(seed: int = 0) -> dict:
    key = jax.random.key(seed)
    ks = jax.random.split(key, 24)
    L, D, W, F, G, T = DEPTH, D_MODEL, BRANCH_WIDTH, D_FF, N_GROUPS, SGU_CHUNK
    nrm = lambda k, shape, s: jax.random.normal(k, shape, jnp.float32) * s
    return {
        "x": nrm(ks[0], (BATCH, SEQ, D), 1.0),
        "c": nrm(ks[1], (BATCH, D), 1.0),
        "ada_w": nrm(ks[2], (L, D, N_SUBLAYERS * N_MOD * D), 0.5 * D ** -0.5),
        "ada_b": nrm(ks[3], (L, N_SUBLAYERS * N_MOD * D), 0.01),
        "pre_g": 1.0 + nrm(ks[4], (L, N_SUBLAYERS, D), 0.05),
        "post_g": 1.0 + nrm(ks[5], (L, N_SUBLAYERS, D), 0.05),
        "ffn_w_in": nrm(ks[6], (L, 2, D, 2 * F), D ** -0.5),
        "ffn_w_out": nrm(ks[7], (L, 2, F, D), F ** -0.5),
        "mix_w_in": nrm(ks[8], (L, D, MIX_IN_WIDTH), D ** -0.5),
        "gate_w": nrm(ks[9], (L, N_BRANCHES, D, D), D ** -0.5),
        "gate_b": nrm(ks[10], (L, N_BRANCHES, D), 0.01),
        "conv_w": nrm(ks[11], (L, CONV_KERNEL, W), CONV_KERNEL ** -0.5),
        "conv_b": nrm(ks[12], (L, W), 0.01),
        "conv_ln_g": 1.0 + nrm(ks[13], (L, W), 0.05),
        "conv_ln_b": nrm(ks[14], (L, W), 0.01),
        "pool_group_w": nrm(ks[15], (L, G, GROUP_WIDTH, GROUP_WIDTH), GROUP_WIDTH ** -0.5),
        "pool_scale": 1.0 + nrm(ks[16], (L, W), 0.05),
        "sgu_ln_g": 1.0 + nrm(ks[17], (L, W), 0.05),
        "sgu_ln_b": nrm(ks[18], (L, W), 0.01),
        "sgu_w_s": nrm(ks[19], (L, G, T, T), T ** -0.5),
        "sgu_b_s": 1.0 + nrm(ks[20], (L, G, T), 0.05),
        "sconv_w": nrm(ks[21], (L, SHORT_CONV_KERNEL, W), SHORT_CONV_KERNEL ** -0.5),
        "branch_w_out": nrm(ks[22], (L, N_BRANCHES, W, D), W ** -0.5),
        "w_o": nrm(ks[23], (L, D, D), D ** -0.5),
    }


def reference(x, c, ada_w, ada_b, pre_g, post_g, ffn_w_in, ffn_w_out, mix_w_in, gate_w, gate_b,
              conv_w, conv_b, conv_ln_g, conv_ln_b, pool_group_w, pool_scale, sgu_ln_g, sgu_ln_b,
              sgu_w_s, sgu_b_s, sconv_w, branch_w_out, w_o):
    b = x.shape[0]
    cond = jax.nn.silu(c)
    for l in range(DEPTH):
        ada = (cond @ ada_w[l] + ada_b[l]).reshape(b, N_SUBLAYERS, N_MOD, D_MODEL)

        n = modulate(rms_norm(x, pre_g[l, 0]), ada[:, 0, 0], ada[:, 0, 1])
        y = rms_norm(swiglu_ffn(n, ffn_w_in[l, 0], ffn_w_out[l, 0]), post_g[l, 0])
        x = x + 0.5 * ada[:, 0, 2][:, None, :] * y

        n = modulate(rms_norm(x, pre_g[l, 1]), ada[:, 1, 0], ada[:, 1, 1])
        p_conv, p_pool, p_sgu, p_sconv = jnp.split(n @ mix_w_in[l], MIX_SPLITS, axis=-1)
        y_conv = conformer_conv_mixer(p_conv, conv_w[l], conv_b[l], conv_ln_g[l], conv_ln_b[l])
        y_pool = multiscale_pool_mixer(p_pool, pool_group_w[l], pool_scale[l])
        y_sgu = spatial_gating_mixer(p_sgu, sgu_ln_g[l], sgu_ln_b[l], sgu_w_s[l], sgu_b_s[l])
        y_sconv = short_conv_mixer(p_sconv, sconv_w[l])
        merged = (jax.nn.sigmoid(n @ gate_w[l, 0] + gate_b[l, 0]) * (y_conv @ branch_w_out[l, 0])
                  + jax.nn.sigmoid(n @ gate_w[l, 1] + gate_b[l, 1]) * (y_pool @ branch_w_out[l, 1])
                  + jax.nn.sigmoid(n @ gate_w[l, 2] + gate_b[l, 2]) * (y_sgu @ branch_w_out[l, 2])
                  + jax.nn.sigmoid(n @ gate_w[l, 3] + gate_b[l, 3]) * (y_sconv @ branch_w_out[l, 3]))
        y = rms_norm(merged @ w_o[l], post_g[l, 1])
        x = x + ada[:, 1, 2][:, None, :] * y

        n = modulate(rms_norm(x, pre_g[l, 2]), ada[:, 2, 0], ada[:, 2, 1])
        y = rms_norm(swiglu_ffn(n, ffn_w_in[l, 1], ffn_w_out[l, 1]), post_g[l, 2])
        x = x + 0.5 * ada[:, 2, 2][:, None, :] * y
    return x
```

```cpp
#include <hip/hip_runtime.h>
#include <cstdio>
#include <cstdint>

namespace pg8 {
#define PG8_LAS __attribute__((address_space(3)))
typedef unsigned short bf16_t;
typedef short bf16x8 __attribute__((ext_vector_type(8)));
typedef float f32x4 __attribute__((ext_vector_type(4)));
typedef float f32x2 __attribute__((ext_vector_type(2)));
typedef unsigned u32x4 __attribute__((ext_vector_type(4)));
typedef unsigned u32x2 __attribute__((ext_vector_type(2)));
constexpr int BM = 256, BK = 64, HALF = 128, HTB = HALF * BK * 2  , STAGE_BYTES = 8 * HTB, NXCD = 8, WGM = 8;

__host__ __device__ __forceinline__ int lds_byte(int r, int c) { const int st = (r >> 4) * 2 + (c >> 5), rr = r & 15, cc = c & 31, ob = rr * 64 + cc * 2; return st * 1024 + (ob ^ (((ob >> 9) & 1) << 5)); }
__host__ __device__ __forceinline__ void stage_rc(int b, int& R, int& C) { const int st = b / 1024, sb = b % 1024, swz = sb ^ (((sb >> 9) & 1) << 5); R = (st >> 1) * 16 + swz / 64; C = (st & 1) * 32 + (swz % 64) / 2; }
__host__ __device__ __forceinline__ int perm32(int rho) { const int n = rho >> 4, i = rho & 15; return 8 * (i >> 2) + 4 * n + (i & 3); }

struct Unit { int pm, pn; };
struct Gemm { const bf16_t* A; const bf16_t* Bt; int M, N, K; };

struct StaticOrder {
    int nM, nN, nwg, G, c;
    __host__ __device__ void init(int M, int N, int G_, int c_, int bn = BM, int bm = BM) { nM = M / bm; nN = N / bn; nwg = nM * nN; G = G_; c = c_; }
    __host__ __device__ bool next(int i, Unit& u) const {
        const long L = (long)i * G + c; if (L >= nwg) return false;
        int wgid = (int)L; { const int q = nwg / NXCD, r = nwg % NXCD, xcd = wgid % NXCD, off = wgid / NXCD; wgid = (xcd < r ? xcd * (q + 1) : r * (q + 1) + (xcd - r) * q) + off; }
        const int nig = WGM * nN, gid = wgid / nig, fm = gid * WGM, gsz = (nM - fm) < WGM ? (nM - fm) : WGM;
        u.pm = fm + ((wgid % nig) % gsz); u.pn = (wgid % nig) / gsz; return true;
    }
    __device__ __forceinline__ void a_ready(const Unit&) const {}
    __device__ __forceinline__ void done(const Unit&) const {}
};

typedef __bf16 bf16x2_native __attribute__((ext_vector_type(2)));
__device__ __forceinline__ unsigned cvt_pk_bf16(float lo, float hi) { const f32x2 v = {lo, hi}; const bf16x2_native r = __builtin_convertvector(v, bf16x2_native); return __builtin_bit_cast(unsigned, r); }
__device__ __forceinline__ f32x2 gelu_pk(f32x2 v) {
    const f32x2 av = __builtin_elementwise_abs(v), d = av * 0.2316418882f + 1.0f;
    f32x2 t; t.x = __builtin_amdgcn_rcpf(d.x); t.y = __builtin_amdgcn_rcpf(d.y);
    f32x2 q = t * 0.5307027145f + (-0.7265760135f); q = q * t + 0.7107068705f; q = q * t + (-0.142248368f); q = q * t + 0.127414796f; q = q * t;
    const f32x2 s = (v * v) * (-0.72134752044f);
    f32x2 e; e.x = __builtin_amdgcn_exp2f(s.x); e.y = __builtin_amdgcn_exp2f(s.y);
    const f32x2 m = v * (q * e), r = v - m;
    f32x2 o; o.x = v.x < 0.f ? m.x : r.x; o.y = v.y < 0.f ? m.y : r.y; return o;
}
__device__ __forceinline__ float sigmoid_f(float x) { return __builtin_amdgcn_rcpf(1.0f + __builtin_amdgcn_exp2f(-1.4426950408889634f * x)); }
__device__ __forceinline__ f32x4 sigmoid4(f32x4 v) { f32x4 o; o[0] = sigmoid_f(v[0]); o[1] = sigmoid_f(v[1]); o[2] = sigmoid_f(v[2]); o[3] = sigmoid_f(v[3]); return o; }
__device__ __forceinline__ f32x4 gelu4(f32x4 v) { const f32x2 a = gelu_pk((f32x2){v[0], v[1]}), b = gelu_pk((f32x2){v[2], v[3]}); return (f32x4){a.x, a.y, b.x, b.y}; }
__device__ __forceinline__ u32x4 pack8(f32x4 v0, f32x4 v1) { u32x4 w; w.x = cvt_pk_bf16(v0[0], v0[1]); w.y = cvt_pk_bf16(v0[2], v0[3]); w.z = cvt_pk_bf16(v1[0], v1[1]); w.w = cvt_pk_bf16(v1[2], v1[3]); return w; }

__device__ __forceinline__ unsigned pk_u8x4(f32x4 g) {
    const unsigned u0 = __float_as_uint(__builtin_fmaf(g[0], 255.0f, 8388608.0f)), u1 = __float_as_uint(__builtin_fmaf(g[1], 255.0f, 8388608.0f)),
                   u2 = __float_as_uint(__builtin_fmaf(g[2], 255.0f, 8388608.0f)), u3 = __float_as_uint(__builtin_fmaf(g[3], 255.0f, 8388608.0f));
    return (u0 & 0xffu) | ((u1 & 0xffu) << 8) | ((u2 & 0xffu) << 16) | (u3 << 24);
}
__device__ __forceinline__ f32x4 u8x4_f32(unsigned w) { return (f32x4){(float)(w & 0xffu), (float)((w >> 8) & 0xffu), (float)((w >> 16) & 0xffu), (float)(w >> 24)}; }
struct EpiF32 {
    static constexpr bool PERM = false, AFTER_DRAIN = false;
    float* C; int ldc;
    __device__ __forceinline__ void operator()(const f32x4 (&acc)[2][2][4][2], const Unit& u, int wr, int wc, int fr, int fq) const {
        const int row0 = u.pm * BM + wr * 64 + fr, col0 = u.pn * BM + wc * 32 + 4 * fq;
#pragma unroll
        for (int ai = 0; ai < 2; ++ai)
#pragma unroll
            for (int m = 0; m < 4; ++m) { float* rowp = C + (size_t)(row0 + ai * HALF + m * 16) * ldc + col0;
#pragma unroll
                for (int bj = 0; bj < 2; ++bj)
#pragma unroll
                    for (int n = 0; n < 2; ++n) *(f32x4*)(rowp + bj * HALF + n * 16) = acc[ai][bj][m][n]; }
    }
};
struct EpiBf16Plain {
    static constexpr bool PERM = true, AFTER_DRAIN = false;
    bf16_t* O; int ldc;
    __device__ __forceinline__ void operator()(const f32x4 (&acc)[2][2][4][2], const Unit& u, int wr, int wc, int fr, int fq) const {
        const int row0 = u.pm * BM + wr * 64 + fr, col0 = u.pn * BM + wc * 32 + 8 * fq;
#pragma unroll
        for (int ai = 0; ai < 2; ++ai)
#pragma unroll
            for (int m = 0; m < 4; ++m) { bf16_t* rowp = O + (size_t)(row0 + ai * HALF + m * 16) * ldc + col0;
#pragma unroll
                for (int bj = 0; bj < 2; ++bj) *(u32x4*)(rowp + bj * HALF) = pack8(acc[ai][bj][m][0], acc[ai][bj][m][1]); }
    }
};
struct EpiSwiGLU {
    static constexpr bool PERM = true, AFTER_DRAIN = false;
    bf16_t* O; int ldc;
    __device__ __forceinline__ void operator()(const f32x4 (&acc)[2][2][4][2], const Unit& u, int wr, int wc, int fr, int fq) const {
        const int row0 = u.pm * BM + wr * 64 + fr, col0 = u.pn * HALF + wc * 32 + 8 * fq;
#pragma unroll
        for (int ai = 0; ai < 2; ++ai)
#pragma unroll
            for (int m = 0; m < 4; ++m) { bf16_t* rowp = O + (size_t)(row0 + ai * HALF + m * 16) * ldc + col0;
                const f32x4 g0 = acc[ai][0][m][0], g1 = acc[ai][0][m][1];
                const f32x4 v0 = g0 * sigmoid4(g0) * acc[ai][1][m][0], v1 = g1 * sigmoid4(g1) * acc[ai][1][m][1];
                *(u32x4*)rowp = pack8(v0, v1); }
    }
};
struct EpiMix {
    static constexpr bool PERM = true, AFTER_DRAIN = false;
    bf16_t* PM; bf16_t* G; const float* gbias; int pn_off;
    __device__ __forceinline__ void operator()(const f32x4 (&acc)[2][2][4][2], const Unit& u, int wr, int wc, int fr, int fq) const {
        const int row0 = u.pm * BM + wr * 64 + fr, pn = u.pn + pn_off, lc = wc * 32 + 8 * fq;
        if (pn >= 16) {
            const int colt = (pn - 16) * BM + lc;
            f32x4 bv[2][2];
#pragma unroll
            for (int bj = 0; bj < 2; ++bj)
#pragma unroll
                for (int n = 0; n < 2; ++n) bv[bj][n] = *(const f32x4*)(gbias + colt + bj * HALF + 4 * n);
#pragma unroll
            for (int ai = 0; ai < 2; ++ai)
#pragma unroll
                for (int m = 0; m < 4; ++m) {
                    unsigned char* rowp = (unsigned char*)G + (size_t)(row0 + ai * HALF + m * 16) * 8192 + (pn - 16) * 256 + (wc * 4 + fq) * 16;
                    u32x4 o; o.x = pk_u8x4(sigmoid4(acc[ai][0][m][0] + bv[0][0])); o.y = pk_u8x4(sigmoid4(acc[ai][0][m][1] + bv[0][1]));
                    o.z = pk_u8x4(sigmoid4(acc[ai][1][m][0] + bv[1][0])); o.w = pk_u8x4(sigmoid4(acc[ai][1][m][1] + bv[1][1]));
                    *(u32x4*)rowp = o; }
        } else if (pn < 4 || pn >= 12) {
            const bool glu = pn < 4; const int colt = (glu ? pn * HALF : 2560 + (pn - 12) * HALF) + lc;
#pragma unroll
            for (int ai = 0; ai < 2; ++ai)
#pragma unroll
                for (int m = 0; m < 4; ++m) { bf16_t* rowp = PM + (size_t)(row0 + ai * HALF + m * 16) * 3072 + colt;
                    f32x4 b0 = acc[ai][1][m][0], b1 = acc[ai][1][m][1];
                    if (glu) { b0 = sigmoid4(b0); b1 = sigmoid4(b1); }
                    *(u32x4*)rowp = pack8(acc[ai][0][m][0] * b0, acc[ai][0][m][1] * b1); }
        } else {
            const bool gl = (pn >= 6 && pn < 10); const int colt = 512 + (pn - 4) * BM + lc;
#pragma unroll
            for (int ai = 0; ai < 2; ++ai)
#pragma unroll
                for (int m = 0; m < 4; ++m) { bf16_t* rowp = PM + (size_t)(row0 + ai * HALF + m * 16) * 3072 + colt;
#pragma unroll
                    for (int bj = 0; bj < 2; ++bj) { f32x4 v0 = acc[ai][bj][m][0], v1 = acc[ai][bj][m][1];
                        if (gl) { v0 = gelu4(v0); v1 = gelu4(v1); }
                        *(u32x4*)(rowp + bj * HALF) = pack8(v0, v1); } }
        }
    }
};

template <class Epi, class Sched, bool ALIGN_EPI = false, bool SP2 = false>
__device__ __forceinline__ void gemm_phase(PG8_LAS unsigned char* lds, const Gemm g, const Sched& S, const Epi& E) {
    int tid_ = threadIdx.x; asm volatile("" : "+v"(tid_));
    const int tid = tid_, wid = __builtin_amdgcn_readfirstlane(tid >> 6), lane = tid & 63, wr = wid >> 2, wc = wid & 3, fr = lane & 15, fq = lane >> 4;
    const int K = g.K, nt = K / BK;
    unsigned voffA[2], voffB[2];
#pragma unroll
    for (int i = 0; i < 2; ++i) { int R, C; stage_rc(tid * 16 + i * 8192, R, C); const int Rb = Epi::PERM ? ((R & ~31) + perm32(R & 31)) : R;
        voffA[i] = (unsigned)(R * K + C) * 2u; voffB[i] = (unsigned)(Rb * K + C) * 2u; }
    const size_t kstep = (size_t)(BK * 2);
    const size_t hstep = (size_t)HALF * K * 2;
    const size_t tstep = 2 * hstep;
    const unsigned ldsw = (unsigned)wid * 1024u;
    const int aoff = lds_byte(wr * 64 + fr, fq * 8), boff = lds_byte(wc * 32 + fr, fq * 8);
#define PG8_SA(b, h) (((b) * 2 + (h)) * HTB)
#define PG8_SB(b, h) ((4 + (b) * 2 + (h)) * HTB)
#define PG8_STAGE(bufoff, gbase, voff) do { _Pragma("unroll") for (int _i = 0; _i < 2; ++_i) \
        __builtin_amdgcn_global_load_lds((const unsigned*)((const char*)(gbase) + (voff)[_i]), (PG8_LAS unsigned*)(lds + (bufoff) + ldsw + _i * 8192), 16, 0, 0); } while (0)
#define PG8_LDA(dst, b, h) do { _Pragma("unroll") for (int m = 0; m < 4; ++m) _Pragma("unroll") for (int k = 0; k < 2; ++k) dst[m][k] = *(const PG8_LAS bf16x8*)(lds + PG8_SA(b, h) + aoff + m * 2048 + k * 1024); } while (0)
#define PG8_LDB(dst, b, h) do { _Pragma("unroll") for (int n = 0; n < 2; ++n) _Pragma("unroll") for (int k = 0; k < 2; ++k) dst[n][k] = *(const PG8_LAS bf16x8*)(lds + PG8_SB(b, h) + boff + n * 2048 + k * 1024); } while (0)
#define PG8_MMA(ai, bj, At, Bt) do { __builtin_amdgcn_s_setprio(1); _Pragma("unroll") for (int m = 0; m < 4; ++m) _Pragma("unroll") for (int n = 0; n < 2; ++n) _Pragma("unroll") for (int k = 0; k < 2; ++k) \
        acc[ai][bj][m][n] = __builtin_amdgcn_mfma_f32_16x16x32_bf16(Bt[n][k], At[m][k], acc[ai][bj][m][n], 0, 0, 0); __builtin_amdgcn_s_setprio(0); } while (0)
#define PG8_WAIT_V(n) asm volatile("s_waitcnt vmcnt(" #n ")" ::: "memory")
#define PG8_WAIT_L(n) asm volatile("s_waitcnt lgkmcnt(" #n ")" ::: "memory")
#define PG8_BAR __builtin_amdgcn_s_barrier()
#define PG8_SCHED __builtin_amdgcn_sched_barrier(0)
    Unit cur, nxt; int ui = 0;
    if (!S.next(0, cur)) return;
    f32x4 acc[2][2][4][2];
#pragma unroll
    for (int a = 0; a < 2; ++a)
#pragma unroll
        for (int b = 0; b < 2; ++b)
#pragma unroll
            for (int m = 0; m < 4; ++m)
#pragma unroll
                for (int n = 0; n < 2; ++n) acc[a][b][m][n] = (f32x4){0.f, 0.f, 0.f, 0.f};
    bf16x8 At[4][2], B0[2][2], B1[2][2];
    const char* cA = (const char*)g.A + (size_t)cur.pm * tstep; const char* cB = (const char*)g.Bt + (size_t)cur.pn * tstep;
    S.a_ready(cur);
    if constexpr (SP2) {
        PG8_STAGE(PG8_SB(0, 0), cB, voffB); PG8_STAGE(PG8_SB(0, 1), cB + hstep, voffB); PG8_STAGE(PG8_SA(0, 0), cA, voffA); PG8_STAGE(PG8_SA(0, 1), cA + hstep, voffA);
        if (wr == 1) PG8_BAR;
        PG8_WAIT_V(2); PG8_BAR;
        PG8_STAGE(PG8_SB(1, 0), cB + kstep, voffB); PG8_STAGE(PG8_SA(1, 0), cA + kstep, voffA); PG8_STAGE(PG8_SB(1, 1), cB + hstep + kstep, voffB);
        PG8_WAIT_V(6); PG8_BAR;
    } else {
        PG8_STAGE(PG8_SB(0, 0), cB, voffB); PG8_STAGE(PG8_SA(0, 0), cA, voffA); PG8_STAGE(PG8_SB(0, 1), cB + hstep, voffB); PG8_STAGE(PG8_SA(0, 1), cA + hstep, voffA);
        if (wr == 1) PG8_BAR;
        PG8_WAIT_V(4); PG8_BAR;
        PG8_STAGE(PG8_SB(1, 0), cB + kstep, voffB); PG8_STAGE(PG8_SA(1, 0), cA + kstep, voffA); PG8_STAGE(PG8_SB(1, 1), cB + hstep + kstep, voffB);
        PG8_WAIT_V(6); PG8_BAR;
    }
    for (;;) {
        const bool has_next = S.next(ui + 1, nxt);
        const char* nA = has_next ? (const char*)g.A + (size_t)nxt.pm * tstep : cA; const char* nB = has_next ? (const char*)g.Bt + (size_t)nxt.pn * tstep : cB;
        for (int t = 0; t < nt; t += 2) {
            const bool last = (t == nt - 2);
            const char* a1 = cA + (size_t)(t + 1) * kstep;
            const char* a2 = last ? nA : cA + (size_t)(t + 2) * kstep; const char* b2 = last ? nB : cB + (size_t)(t + 2) * kstep;
            const char* a3 = a2 + kstep; const char* b3 = b2 + kstep;
            if (last && has_next) S.a_ready(nxt);
            if constexpr (SP2) {
            PG8_LDB(B0, 0, 0); PG8_LDB(B1, 0, 1); PG8_SCHED; PG8_LDA(At, 0, 0); PG8_STAGE(PG8_SA(1, 1), a1 + hstep, voffA);
            PG8_WAIT_V(8); PG8_WAIT_L(0); PG8_BAR; PG8_MMA(0, 0, At, B0); PG8_MMA(0, 1, At, B1); PG8_BAR; PG8_SCHED;
            PG8_LDA(At, 0, 1); PG8_STAGE(PG8_SB(0, 0), b2, voffB); PG8_STAGE(PG8_SB(0, 1), b2 + hstep, voffB); PG8_STAGE(PG8_SA(0, 0), a2, voffA);
            PG8_WAIT_V(8); PG8_WAIT_L(0); PG8_BAR; PG8_MMA(1, 0, At, B0); PG8_MMA(1, 1, At, B1); PG8_BAR; PG8_SCHED;
            PG8_LDB(B0, 1, 0); PG8_LDB(B1, 1, 1); PG8_SCHED; PG8_LDA(At, 1, 0); PG8_STAGE(PG8_SA(0, 1), a2 + hstep, voffA);
            PG8_WAIT_V(8); PG8_WAIT_L(0); PG8_BAR; PG8_MMA(0, 0, At, B0); PG8_MMA(0, 1, At, B1); PG8_BAR; PG8_SCHED;
            PG8_LDA(At, 1, 1); PG8_STAGE(PG8_SB(1, 0), b3, voffB); PG8_STAGE(PG8_SB(1, 1), b3 + hstep, voffB); PG8_STAGE(PG8_SA(1, 0), a3, voffA);
            PG8_WAIT_V(8); PG8_WAIT_L(0); PG8_BAR; PG8_MMA(1, 0, At, B0); PG8_MMA(1, 1, At, B1); PG8_BAR; PG8_SCHED;
            } else {
            PG8_LDB(B0, 0, 0); PG8_SCHED; PG8_LDA(At, 0, 0); PG8_STAGE(PG8_SA(1, 1), a1 + hstep, voffA);
            PG8_WAIT_L(8); PG8_BAR; PG8_WAIT_L(0); PG8_MMA(0, 0, At, B0); PG8_BAR; PG8_SCHED;
            PG8_LDB(B1, 0, 1); PG8_STAGE(PG8_SB(0, 0), b2, voffB);
            PG8_BAR; PG8_WAIT_L(0); PG8_MMA(0, 1, At, B1); PG8_BAR;
            PG8_LDA(At, 0, 1); PG8_STAGE(PG8_SA(0, 0), a2, voffA);
            PG8_BAR; PG8_WAIT_L(0); PG8_MMA(1, 0, At, B0); PG8_BAR; PG8_SCHED;
            PG8_STAGE(PG8_SB(0, 1), b2 + hstep, voffB);
            PG8_WAIT_V(6); PG8_BAR; PG8_MMA(1, 1, At, B1); PG8_BAR;
            PG8_LDB(B0, 1, 0); PG8_SCHED; PG8_LDA(At, 1, 0); PG8_STAGE(PG8_SA(0, 1), a2 + hstep, voffA);
            PG8_WAIT_L(8); PG8_BAR; PG8_WAIT_L(0); PG8_MMA(0, 0, At, B0); PG8_BAR; PG8_SCHED;
            PG8_LDB(B1, 1, 1); PG8_STAGE(PG8_SB(1, 0), b3, voffB);
            PG8_BAR; PG8_WAIT_L(0); PG8_MMA(0, 1, At, B1); PG8_BAR;
            PG8_LDA(At, 1, 1); PG8_STAGE(PG8_SA(1, 0), a3, voffA);
            PG8_BAR; PG8_WAIT_L(0); PG8_MMA(1, 0, At, B0); PG8_BAR; PG8_SCHED;
            PG8_STAGE(PG8_SB(1, 1), b3 + hstep, voffB);
            PG8_WAIT_V(6); PG8_BAR; PG8_MMA(1, 1, At, B1); PG8_BAR;
            }
        }
        if constexpr (ALIGN_EPI) { if (wr == 0) PG8_BAR; }
        if constexpr (!Epi::AFTER_DRAIN) { E(acc, cur, wr, wc, fr, fq); S.done(cur); }
        if (!has_next) break;
#pragma unroll
        for (int a = 0; a < 2; ++a)
#pragma unroll
            for (int b = 0; b < 2; ++b)
#pragma unroll
                for (int m = 0; m < 4; ++m)
#pragma unroll
                    for (int n = 0; n < 2; ++n) acc[a][b][m][n] = (f32x4){0.f, 0.f, 0.f, 0.f};
        cur = nxt; cA = nA; cB = nB; ++ui;
        if constexpr (ALIGN_EPI) { if (wr == 1) PG8_BAR; }
    }
    PG8_WAIT_V(0);
    if constexpr (!ALIGN_EPI) { if (wr == 0) PG8_BAR; }
    PG8_BAR;
    if constexpr (Epi::AFTER_DRAIN) { E.fused(acc, cur, wr, wc, fr, fq, lds, wid, lane); S.done(cur); }
#undef PG8_SA
#undef PG8_SB
#undef PG8_STAGE
#undef PG8_LDA
#undef PG8_LDB
#undef PG8_MMA
#undef PG8_WAIT_V
#undef PG8_WAIT_L
#undef PG8_BAR
#undef PG8_SCHED
}

template <class Sched>
__device__ __forceinline__ void gated_merge3_phase(PG8_LAS unsigned char* lds, const bf16_t* A, const bf16_t* Bt, const bf16_t* Gt, bf16_t* O, const Sched& S) {
    int tid_ = threadIdx.x; asm volatile("" : "+v"(tid_));
    const int tid = tid_, wid = __builtin_amdgcn_readfirstlane(tid >> 6), lane = tid & 63, wr = wid >> 2, wc = wid & 3, fr = lane & 15, fq = lane >> 4;
    constexpr int K = 2048, nt = K / BK, STG = 3 * HTB;
    unsigned voffA[2], voffB[2];
#pragma unroll
    for (int i = 0; i < 2; ++i) { int R, C; stage_rc(tid * 16 + i * 8192, R, C); const int Rb = (R & ~31) + perm32(R & 31);
        voffA[i] = (unsigned)(R * K + C) * 2u; voffB[i] = (unsigned)(Rb * K + C) * 2u; }
    const size_t kstep = (size_t)(BK * 2);
    const size_t hstep = (size_t)HALF * K * 2;
    const size_t tstepA = hstep, tstepB = 2 * hstep;
    const unsigned ldsw = (unsigned)wid * 1024u;
    const int aoff = lds_byte(wr * 64 + fr, fq * 8) + 2 * HTB, boff = lds_byte(wc * 32 + fr, fq * 8);
#define M3_STAGE1(dst, gbase, voff) do { _Pragma("unroll") for (int _i = 0; _i < 2; ++_i) \
        __builtin_amdgcn_global_load_lds((const unsigned*)((const char*)(gbase) + (voff)[_i]), (PG8_LAS unsigned*)(lds + (dst) + ldsw + _i * 8192), 16, 0, 0); } while (0)
#define M3_STAGE(so, ap, bp) do { M3_STAGE1((so), (bp), voffB); M3_STAGE1((so) + HTB, (bp) + hstep, voffB); M3_STAGE1((so) + 2 * HTB, (ap), voffA); } while (0)
#define M3_WAIT_V(n) asm volatile("s_waitcnt vmcnt(" #n ")" ::: "memory")
#define M3_WAIT_L(n) asm volatile("s_waitcnt lgkmcnt(" #n ")" ::: "memory")
#define M3_BAR __builtin_amdgcn_s_barrier()
#define M3_SCHED __builtin_amdgcn_sched_barrier(0)
    Unit cur, nxt; int ui = 0;
    if (!S.next(0, cur)) return;
    f32x4 acc[2][4][2], mm[2][4][2];
#pragma unroll
    for (int a = 0; a < 2; ++a)
#pragma unroll
        for (int m = 0; m < 4; ++m)
#pragma unroll
            for (int n = 0; n < 2; ++n) { acc[a][m][n] = (f32x4){0.f, 0.f, 0.f, 0.f}; mm[a][m][n] = (f32x4){0.f, 0.f, 0.f, 0.f}; }
    bf16x8 At[4][2], B0[2][2], B1[2][2];
    u32x4 gp[4];
    const char* cA = (const char*)A + (size_t)cur.pm * tstepA; const char* cB = (const char*)Bt + (size_t)cur.pn * tstepB;
    M3_STAGE(0, cA, cB);
    if (wr == 1) M3_BAR;
    M3_WAIT_V(0); M3_BAR;
    M3_STAGE(STG, cA + kstep, cB + kstep);
    M3_BAR;
    int rs = 0;
    for (;;) {
        const bool has_next = S.next(ui + 1, nxt);
        const char* nA = has_next ? (const char*)A + (size_t)nxt.pm * tstepA : cA; const char* nB = has_next ? (const char*)Bt + (size_t)nxt.pn * tstepB : cB;
        const int grow0 = cur.pm * HALF + wr * 64 + fr, gcol0 = cur.pn * BM + wc * 32 + 8 * fq;
        for (int t = 0; t < nt; ++t) {
            const int t2 = t + 2; const bool wrap = t2 >= nt;
            const char* a2 = wrap ? nA + (size_t)(t2 - nt) * kstep : cA + (size_t)t2 * kstep;
            const char* b2 = wrap ? nB + (size_t)(t2 - nt) * kstep : cB + (size_t)t2 * kstep;
            const int ro = rs * STG; int ws2 = rs + 2; ws2 = ws2 >= 3 ? ws2 - 3 : ws2; const int so = ws2 * STG;
            const bool segend = ((t & 7) == 7);
            const bool gpre = ((t & 7) == 6);
            if (gpre) {
                const unsigned char* gb = (const unsigned char*)Gt + (size_t)grow0 * 8192 + ((t >> 3) * 8 + cur.pn) * 256 + (wc * 4 + fq) * 16;
#pragma unroll
                for (int m = 0; m < 4; ++m) gp[m] = *(const u32x4*)(gb + (size_t)(m * 16) * 8192);
            }
#pragma unroll
            for (int n = 0; n < 2; ++n)
#pragma unroll
                for (int k = 0; k < 2; ++k) { B0[n][k] = *(const PG8_LAS bf16x8*)(lds + ro + boff + n * 2048 + k * 1024); B1[n][k] = *(const PG8_LAS bf16x8*)(lds + ro + HTB + boff + n * 2048 + k * 1024); }
            M3_SCHED;
#pragma unroll
            for (int m = 0; m < 4; ++m)
#pragma unroll
                for (int k = 0; k < 2; ++k) At[m][k] = *(const PG8_LAS bf16x8*)(lds + ro + aoff + m * 2048 + k * 1024);
            M3_STAGE(so, a2, b2);
            if (gpre) M3_WAIT_V(10); else M3_WAIT_V(6);
            M3_WAIT_L(0); M3_BAR;
            __builtin_amdgcn_s_setprio(1);
#pragma unroll
            for (int m = 0; m < 4; ++m)
#pragma unroll
                for (int n = 0; n < 2; ++n)
#pragma unroll
                    for (int k = 0; k < 2; ++k) { acc[0][m][n] = __builtin_amdgcn_mfma_f32_16x16x32_bf16(B0[n][k], At[m][k], acc[0][m][n], 0, 0, 0);
                                                  acc[1][m][n] = __builtin_amdgcn_mfma_f32_16x16x32_bf16(B1[n][k], At[m][k], acc[1][m][n], 0, 0, 0); }
            __builtin_amdgcn_s_setprio(0);
            M3_BAR; M3_SCHED;
            rs = rs + 1; rs = rs >= 3 ? 0 : rs;
            if (segend) {
#pragma unroll
                for (int m = 0; m < 4; ++m) { const u32x4 g = gp[m];
                    mm[0][m][0] += u8x4_f32(g.x) * acc[0][m][0]; mm[0][m][1] += u8x4_f32(g.y) * acc[0][m][1];
                    mm[1][m][0] += u8x4_f32(g.z) * acc[1][m][0]; mm[1][m][1] += u8x4_f32(g.w) * acc[1][m][1];
#pragma unroll
                    for (int bj = 0; bj < 2; ++bj) { acc[bj][m][0] = (f32x4){0.f, 0.f, 0.f, 0.f}; acc[bj][m][1] = (f32x4){0.f, 0.f, 0.f, 0.f}; } }
            }
        }
#pragma unroll
        for (int bj = 0; bj < 2; ++bj)
#pragma unroll
            for (int m = 0; m < 4; ++m) { *(u32x4*)(O + (size_t)(grow0 + m * 16) * 2048 + gcol0 + bj * HALF) = pack8(mm[bj][m][0] * (1.0f / 255.0f), mm[bj][m][1] * (1.0f / 255.0f));
                mm[bj][m][0] = (f32x4){0.f, 0.f, 0.f, 0.f}; mm[bj][m][1] = (f32x4){0.f, 0.f, 0.f, 0.f}; }
        if (!has_next) break;
        cur = nxt; cA = nA; cB = nB; ++ui;
    }
    M3_WAIT_V(0);
    if (wr == 0) M3_BAR;
    M3_BAR;
#undef M3_STAGE1
#undef M3_STAGE
#undef M3_WAIT_V
#undef M3_WAIT_L
#undef M3_BAR
#undef M3_SCHED
}
}

#ifndef PG8_SP2
#define PG8_SP2 true
#endif
#ifndef PG8_ALIGN
#define PG8_ALIGN true
#endif
#ifndef MK_PER_PHASE
#define MK_PER_PHASE 0
#endif

constexpr int S = 16384, D = 2048, FF = 5632, BW = 512, NL = 2;
constexpr int NMIXG = 12288;
constexpr int PMW = 3072;
constexpr int NADA = 9 * D;
constexpr float RMS_EPS = 1e-6f, LN_EPS = 1e-5f;
constexpr int NWAVES = 8, NTHREADS = NWAVES * 64;
constexpr int NPHASES = 2 + 11 * NL;

constexpr size_t MiB = 1u << 20;
constexpr size_t WS_CTL = 0, CTL_ZERO_BYTES = 1 * MiB;
constexpr size_t WS_ADAP = 1 * MiB;
constexpr size_t WS_POOLW = 2 * MiB;
constexpr size_t WS_SGUW = 2 * MiB + 256 * 1024;
constexpr size_t WS_WIN = 3 * MiB;
constexpr size_t WS_WOUT = WS_WIN + 176 * MiB;
constexpr size_t WS_WMIX = WS_WOUT + 88 * MiB;
constexpr size_t WS_WBR = WS_WMIX + 96 * MiB;
constexpr size_t WS_WO = WS_WBR + 16 * MiB;
constexpr size_t WS_NBUF = WS_WO + 16 * MiB;
constexpr size_t WS_ACT = WS_NBUF + 64 * MiB;
constexpr size_t WS_Z = WS_ACT + 176 * MiB;
constexpr size_t WS_PM = WS_Z + 128 * MiB;
constexpr size_t WS_G = WS_PM + 96 * MiB;
constexpr size_t WS_Y = WS_G + 256 * MiB;
constexpr size_t WS_MG = WS_Y + 64 * MiB;
constexpr size_t WS_XB = WS_MG + 64 * MiB;
constexpr size_t WS_END = WS_XB + 64 * MiB;
static_assert((size_t)NL * 2 * 2 * FF * D * 2 == 176 * MiB && (size_t)NL * 2 * D * FF * 2 == 88 * MiB && (size_t)NL * NMIXG * D * 2 == 96 * MiB, "weight map");
static_assert((size_t)S * FF * 2 == 176 * MiB && (size_t)S * PMW * 2 == 96 * MiB && (size_t)S * 8192 * 2 == 256 * MiB, "activation map");
constexpr int CW_TMO = 0, CW_CODE = 1;
constexpr int CW_BAR = 4096;

constexpr int RING_OFF = 0, RING_BYTES = 147456;
constexpr int LDSCTL_OFF = RING_BYTES, MISC_OFF = LDSCTL_OFF + 320;
constexpr int LDS_BYTES = 163840;
static_assert(MISC_OFF + 128 <= LDS_BYTES, "LDS map");

#define GAS __attribute__((address_space(1)))
#define LAS __attribute__((address_space(3)))
typedef unsigned short bf16;
typedef unsigned v4u __attribute__((ext_vector_type(4)));
typedef unsigned v2u __attribute__((ext_vector_type(2)));
typedef float f32x4 __attribute__((ext_vector_type(4)));
typedef float f32x2 __attribute__((ext_vector_type(2)));
typedef short bf16x8 __attribute__((ext_vector_type(8)));
typedef GAS unsigned gu32;
#define RLX_AGENT __ATOMIC_RELAXED, __HIP_MEMORY_SCOPE_AGENT
#define LDS_WAIT() asm volatile("s_waitcnt lgkmcnt(0)" ::: "memory")
#define VM_WAIT() asm volatile("s_waitcnt vmcnt(0)" ::: "memory")
__device__ __forceinline__ unsigned f2bf(float f) { unsigned u = __builtin_bit_cast(unsigned, f); return (u + 0x7fffu + ((u >> 16) & 1u)) >> 16; }
__device__ __forceinline__ unsigned pk2(float lo, float hi) { return pg8::cvt_pk_bf16(lo, hi); }
__device__ __forceinline__ float bf_lo(unsigned w) { return __uint_as_float(w << 16); }
__device__ __forceinline__ float bf_hi(unsigned w) { return __uint_as_float(w & 0xffff0000u); }
__device__ __forceinline__ float wave_sum(float v) {
#pragma unroll
    for (int o = 1; o < 64; o <<= 1) v += __shfl_xor(v, o);
    return v;
}
template <int N> __device__ __forceinline__ void wave_sum_n(float (&v)[N]) {
#pragma unroll
    for (int o = 1; o < 64; o <<= 1) {
        float t[N];
#pragma unroll
        for (int i = 0; i < N; ++i) t[i] = __shfl_xor(v[i], o);
#pragma unroll
        for (int i = 0; i < N; ++i) v[i] += t[i];
    }
}
#define XB_TMO      128
#define XB_XCNT(j)  (256  + 64 * (j))
#define XB_XSUB(j)  (1280 + 64 * (j))
#define XB_XGEN(j)  (2304 + 64 * (j))
#define XB_TOP      3328
#define XB_TOPGEN   3392
#define XCD_BAR_WORDS 3456
#define XB_SPIN_CAP (1u << 18)

__device__ __forceinline__ unsigned xb_ld(unsigned* p)              { return __hip_atomic_load(p, __ATOMIC_RELAXED, __HIP_MEMORY_SCOPE_AGENT); }
__device__ __forceinline__ unsigned xb_add(unsigned* p, unsigned v) { return __hip_atomic_fetch_add(p, v, __ATOMIC_RELAXED, __HIP_MEMORY_SCOPE_AGENT); }
__device__ __forceinline__ unsigned xb_xcc_id() { return (unsigned)__builtin_amdgcn_s_getreg((3 << 11) | 20) & 0xFu; }
#define XB_SPIN(cond, bar) do { unsigned _sp = 0; while (cond) { __builtin_amdgcn_s_sleep(1); \
    if ((++_sp & 255u) == 0u) { if (xb_ld(&(bar)[XB_TMO])) break; if (_sp > XB_SPIN_CAP) { atomicAdd(&(bar)[XB_TMO], 1u); break; } } } } while (0)

struct XcdBarrier {
    unsigned* bar; unsigned x;
    volatile LAS unsigned* st;
};

__device__ __forceinline__ XcdBarrier xcd_barrier_post(unsigned* bar, volatile LAS unsigned* st) {
    XcdBarrier b; b.bar = bar; b.x = xb_xcc_id(); b.st = st;
    if (threadIdx.x == 0) (void)xb_add(&bar[XB_XCNT(b.x)], 1u);
    return b;
}
__device__ __forceinline__ void xcd_barrier_complete(unsigned* bar, unsigned x, unsigned& nloc, unsigned& nx) {
    const unsigned G = gridDim.x * gridDim.y * gridDim.z;
    unsigned sum, cnt, mine, sp = 0u;
    for (;;) {
        sum = 0u; cnt = 0u; mine = 0u;
#pragma unroll
        for (unsigned j = 0; j < 16; ++j) { const unsigned c = xb_ld(&bar[XB_XCNT(j)]); sum += c; cnt += (c > 0u) ? 1u : 0u; mine = (j == x) ? c : mine; }
        if (sum == G) break;
        __builtin_amdgcn_s_sleep(1);
        if ((++sp & 255u) == 0u) { if (xb_ld(&bar[XB_TMO])) break; if (sp > XB_SPIN_CAP) { atomicAdd(&bar[XB_TMO], 1u); break; } }
    }
    nloc = mine > 0u ? mine : 1u; nx = cnt > 0u ? cnt : 1u;
}

__device__ __forceinline__ void xcd_barrier(const XcdBarrier& b) {
    asm volatile("s_waitcnt vmcnt(0)" ::: "memory");
    __syncthreads();
    if (threadIdx.x == 0) {
        unsigned* bar = b.bar;
        __builtin_amdgcn_s_waitcnt(0);
        unsigned nloc = b.st[0], nx = b.st[1];
        if (nloc == 0u) { xcd_barrier_complete(bar, b.x, nloc, nx); b.st[0] = nloc; b.st[1] = nx; }
        const unsigned old = xb_add(&bar[XB_XSUB(b.x)], 1u);
        const unsigned gen = old / nloc;
        if (old + 1u == (gen + 1u) * nloc) {
            __builtin_amdgcn_fence(__ATOMIC_RELEASE, "agent");
            asm volatile("s_waitcnt vmcnt(0)" ::: "memory");
            const unsigned og = xb_add(&bar[XB_TOP], 1u);
            const unsigned tg = og / nx;
            if (og + 1u == (tg + 1u) * nx) xb_add(&bar[XB_TOPGEN], 1u);
            else XB_SPIN(xb_ld(&bar[XB_TOPGEN]) == tg, bar);
            __builtin_amdgcn_fence(__ATOMIC_ACQUIRE, "agent");
            xb_add(&bar[XB_XGEN(b.x)], 1u);
            asm volatile("s_waitcnt vmcnt(0)" ::: "memory");
        } else {
            XB_SPIN(xb_ld(&bar[XB_XGEN(b.x)]) == gen, bar);
            __builtin_amdgcn_fence(__ATOMIC_ACQUIRE, "agent");
            asm volatile("s_waitcnt vmcnt(0)" ::: "memory");
        }
    }
    __syncthreads();
}


struct TrJob { const float* src; bf16* dst; int ldw, ldk; };
__device__ __forceinline__ void tr_load(const TrJob& j, f32x4 (&v)[8][2], int lane) {
    const int rsub = lane >> 4, cg = lane & 15;
#pragma unroll
    for (int jp = 0; jp < 8; ++jp)
#pragma unroll
        for (int par = 0; par < 2; ++par) v[jp][par] = *(const f32x4*)(j.src + (size_t)(8 * jp + 2 * rsub + par) * j.ldw + 4 * cg);
}
__device__ __forceinline__ void tr_finish(const TrJob& j, const f32x4 (&v)[8][2], LAS unsigned* scr, int lane) {
    const int rsub = lane >> 4, cg = lane & 15;
#pragma unroll
    for (int jp = 0; jp < 8; ++jp)
#pragma unroll
        for (int e = 0; e < 4; ++e) scr[(4 * jp + rsub) * 65 + 4 * cg + e] = pk2(v[jp][0][e], v[jp][1][e]);
    LDS_WAIT(); asm volatile("" ::: "memory");
    const int nl = lane >> 3, c = lane & 7;
#pragma unroll
    for (int jj = 0; jj < 8; ++jj) { const int n = nl + 8 * jj; v4u o;
        o.x = scr[(4 * c + 0) * 65 + n]; o.y = scr[(4 * c + 1) * 65 + n]; o.z = scr[(4 * c + 2) * 65 + n]; o.w = scr[(4 * c + 3) * 65 + n];
        *(v4u*)(j.dst + (size_t)n * j.ldk + 8 * c) = o; }
    LDS_WAIT(); asm volatile("" ::: "memory");
}
constexpr int CONV_ITEMS_PER_LAYER = 25104, N_ADA_ITEMS = 2304, N_SGU_ITEMS = 256;
constexpr int N_P0_ITEMS = N_ADA_ITEMS + NL * CONV_ITEMS_PER_LAYER + N_SGU_ITEMS;

struct Args { const float* in[24]; float* out; unsigned char* ws; int ph_lo, ph_hi; };


typedef const __attribute__((address_space(4))) Args* KArgs;
__device__ __forceinline__ KArgs kargs() { KArgs p = (KArgs)__builtin_amdgcn_kernarg_segment_ptr(); asm volatile("" : "+s"(p)); return p; }
__device__ __forceinline__ TrJob p0_conv_job(KArgs a, int it) {
    unsigned char* ws = a->ws;
    const int l = it / CONV_ITEMS_PER_LAYER; int r = it % CONV_ITEMS_PER_LAYER;
    const float* src; int ldw; bf16* dst; int ldk;
    if (r < 11264) { const int i = r / 5632; r %= 5632; const int kb = r / 176, nb = r % 176, n0 = 64 * nb, pn = n0 >> 8, s = (n0 >> 7) & 1, r0 = n0 & 127;
        src = a->in[6] + ((size_t)(l * 2 + i) * D + 64 * kb) * (2 * FF) + s * FF + 128 * pn + r0; ldw = 2 * FF;
        dst = (bf16*)(ws + WS_WIN) + ((size_t)(l * 2 + i) * 2 * FF + n0) * D + 64 * kb; ldk = D; }
    else if ((r -= 11264) < 5632) { const int i = r / 2816; r %= 2816; const int kb = r / 32, nb = r % 32, n0 = 64 * nb;
        src = a->in[7] + ((size_t)(l * 2 + i) * FF + 64 * kb) * D + n0; ldw = D;
        dst = (bf16*)(ws + WS_WOUT) + ((size_t)(l * 2 + i) * D + n0) * FF + 64 * kb; ldk = FF; }
    else if ((r -= 5632) < 2048) { const int kb = r / 64, nb = r % 64, n0 = 64 * nb, t = n0 >> 8, rr = n0 & 255; int sc;
        if (t < 4) sc = (rr >> 7) * 512 + 128 * t + (rr & 127); else if (t < 12) sc = 1024 + (t - 4) * 256 + rr; else sc = 3072 + (rr >> 7) * 512 + 128 * (t - 12) + (rr & 127);
        src = a->in[8] + ((size_t)l * D + 64 * kb) * 4096 + sc; ldw = 4096;
        dst = (bf16*)(ws + WS_WMIX) + ((size_t)l * NMIXG + n0) * D + 64 * kb; ldk = D; }
    else if ((r -= 2048) < 4096) { const int b = r / 1024; r %= 1024; const int kb = r / 32, nb = r % 32, n0 = 64 * nb;
        src = a->in[9] + ((size_t)(l * 4 + b) * D + 64 * kb) * D + n0; ldw = D;
        dst = (bf16*)(ws + WS_WMIX) + ((size_t)l * NMIXG + 4096 + b * 2048 + n0) * D + 64 * kb; ldk = D; }
    else if ((r -= 4096) < 1024) { const int b = r / 256; r %= 256; const int kb = r / 32, nb = r % 32, n0 = 64 * nb;
        src = a->in[22] + ((size_t)(l * 4 + b) * BW + 64 * kb) * D + n0; ldw = D;
        dst = (bf16*)(ws + WS_WBR) + ((size_t)l * D + n0) * 2048 + b * 512 + 64 * kb; ldk = 2048; }
    else if ((r -= 1024) < 1024) { const int kb = r / 32, nb = r % 32, n0 = 64 * nb;
        src = a->in[23] + ((size_t)l * D + 64 * kb) * D + n0; ldw = D;
        dst = (bf16*)(ws + WS_WO) + ((size_t)l * D + n0) * D + 64 * kb; ldk = D; }
    else { r -= 1024; const int g = r / 4; r %= 4; const int kb = r / 2, nb = r % 2, n0 = 64 * nb;
        src = a->in[15] + ((size_t)(l * 4 + g) * 128 + 64 * kb) * 128 + n0; ldw = 128;
        dst = (bf16*)(ws + WS_POOLW) + ((size_t)(l * 4 + g) * 128 + n0) * 128 + 64 * kb; ldk = 128; }
    TrJob j; j.src = src; j.dst = dst; j.ldw = ldw; j.ldk = ldk; return j;
}
__device__ __forceinline__ void p0_ada_item(KArgs a, int it, int lane) {
    const int ks = it / 576, cb = it % 576, col = cb * 64 + lane, l = col / NADA, j = col % NADA;
    const float* w = a->in[2] + ((size_t)l * D + ks * 512) * NADA + j; const float* cvec = a->in[1] + ks * 512;
    float acc = 0.f;
    for (int k0 = 0; k0 < 512; k0 += 64) {
        float cv = cvec[k0 + lane]; cv = cv / (1.0f + __expf(-cv));
#pragma unroll 16
        for (int i = 0; i < 64; ++i) acc += __uint_as_float((unsigned)__builtin_amdgcn_readlane((int)__float_as_uint(cv), i)) * w[(size_t)(k0 + i) * NADA];
    }
    ((float*)(a->ws + WS_ADAP))[(size_t)ks * (NL * NADA) + col] = acc;
}
__device__ __forceinline__ void p0_sgu_item(KArgs a, int it, int lane) {
    const int e = it * 512 + lane * 8, t = (e >> 7) & 127, j0 = e & 127;
    const f32x4 v0 = *(const f32x4*)(a->in[19] + e), v1 = *(const f32x4*)(a->in[19] + e + 4);
    float x[8] = {v0[0], v0[1], v0[2], v0[3], v1[0], v1[1], v1[2], v1[3]};
#pragma unroll
    for (int i = 0; i < 8; ++i) x[i] = (j0 + i <= t) ? x[i] : 0.f;
    v4u o; o.x = pk2(x[0], x[1]); o.y = pk2(x[2], x[3]); o.z = pk2(x[4], x[5]); o.w = pk2(x[6], x[7]);
    *(v4u*)((bf16*)(a->ws + WS_SGUW) + e) = o;
}
__device__ __forceinline__ float ada_val(const float* adap, const float* ada_b, int idx) {
    return ada_b[idx] + ((adap[idx] + adap[NL * NADA + idx]) + (adap[2 * NL * NADA + idx] + adap[3 * NL * NADA + idx]));
}

template <bool HAS_RES, bool HAS_NEXT, bool XIN_F32, bool XOUT_F32>
__device__ __forceinline__ void resnorm_phase(LAS unsigned char* lds, const void* xin_, void* xout_, const bf16* z, bf16* nbuf, const float* adap, const float* ada_b,
                                              const float* post_g, int off_gate, float coef, const float* pre_g_next, int off_next, int gw, int NGW, int tid, int lane) {
    asm volatile("" : "+v"(tid)); lane = tid & 63;
    LAS float* vA = (LAS float*)lds; LAS float* vB = vA + D; LAS float* vC = vB + D;
    for (int d = tid; d < D; d += NTHREADS) {
        if (HAS_RES) vA[d] = coef * ada_val(adap, ada_b, off_gate + d) * post_g[d];
        if (HAS_NEXT) { vB[d] = pre_g_next[d] * (1.0f + ada_val(adap, ada_b, off_next + D + d)); vC[d] = ada_val(adap, ada_b, off_next + d); }
    }
    __syncthreads();
    const float* xinf = (const float*)xin_; const bf16* xinb = (const bf16*)xin_; float* xoutf = (float*)xout_; bf16* xoutb = (bf16*)xout_;
    for (int row0 = gw; row0 < S; row0 += 2 * NGW) {
        f32x4 xf[2][8]; v2u xc[2][8], zc[2][8];
#pragma unroll
        for (int r = 0; r < 2; ++r) { int row = row0 + r * NGW; asm volatile("" : "+s"(row));
            if (XIN_F32) { const f32x4* xr = (const f32x4*)(xinf + (size_t)row * D) + lane;
#pragma unroll
                for (int j = 0; j < 8; ++j) xf[r][j] = xr[64 * j];
            } else { const v2u* xr = (const v2u*)(xinb + (size_t)row * D) + lane;
#pragma unroll
                for (int j = 0; j < 8; ++j) xc[r][j] = xr[64 * j]; }
            if (HAS_RES) { const v2u* zr = (const v2u*)(z + (size_t)row * D) + lane;
#pragma unroll
                for (int j = 0; j < 8; ++j) zc[r][j] = zr[64 * j]; }
        }
#pragma unroll
        for (int r = 0; r < 2; ++r) { int row = row0 + r * NGW; asm volatile("" : "+s"(row));
            f32x4 xv[8];
#pragma unroll
            for (int j = 0; j < 8; ++j) xv[j] = XIN_F32 ? xf[r][j] : (f32x4){bf_lo(xc[r][j].x), bf_hi(xc[r][j].x), bf_lo(xc[r][j].y), bf_hi(xc[r][j].y)};
            if (HAS_RES) {
                f32x4 zv[8]; float ss = 0.f;
#pragma unroll
                for (int j = 0; j < 8; ++j) { const v2u zz = zc[r][j]; zv[j] = (f32x4){bf_lo(zz.x), bf_hi(zz.x), bf_lo(zz.y), bf_hi(zz.y)}; ss += (zv[j][0] * zv[j][0] + zv[j][1] * zv[j][1]) + (zv[j][2] * zv[j][2] + zv[j][3] * zv[j][3]); }
                const float rz = rsqrtf(wave_sum(ss) * (1.0f / D) + RMS_EPS);
#pragma unroll
                for (int j = 0; j < 8; ++j) { const f32x4 av = *(const LAS f32x4*)(vA + 4 * lane + 256 * j); xv[j] = xv[j] + av * zv[j] * rz; }
                if (XOUT_F32) { f32x4* xo = (f32x4*)(xoutf + (size_t)row * D) + lane;
#pragma unroll
                    for (int j = 0; j < 8; ++j) xo[64 * j] = xv[j];
                } else { v2u* xo = (v2u*)(xoutb + (size_t)row * D) + lane;
#pragma unroll
                    for (int j = 0; j < 8; ++j) { v2u o; o.x = pk2(xv[j][0], xv[j][1]); o.y = pk2(xv[j][2], xv[j][3]); xo[64 * j] = o;
                        xv[j] = (f32x4){bf_lo(o.x), bf_hi(o.x), bf_lo(o.y), bf_hi(o.y)}; }
                }
            }
            if (HAS_NEXT) {
                float ss = 0.f;
#pragma unroll
                for (int j = 0; j < 8; ++j) ss += (xv[j][0] * xv[j][0] + xv[j][1] * xv[j][1]) + (xv[j][2] * xv[j][2] + xv[j][3] * xv[j][3]);
                const float rx = rsqrtf(wave_sum(ss) * (1.0f / D) + RMS_EPS);
                v2u* no = (v2u*)(nbuf + (size_t)row * D) + lane;
#pragma unroll
                for (int j = 0; j < 8; ++j) { const f32x4 bv = *(const LAS f32x4*)(vB + 4 * lane + 256 * j), cv = *(const LAS f32x4*)(vC + 4 * lane + 256 * j);
                    const f32x4 n = xv[j] * rx * bv + cv; v2u o; o.x = pk2(n[0], n[1]); o.y = pk2(n[2], n[3]); no[64 * j] = o; }
            }
        }
    }
    __syncthreads();
}

__device__ __forceinline__ void unpack8(const v4u r, float (&x)[8]) { x[0] = bf_lo(r.x); x[1] = bf_hi(r.x); x[2] = bf_lo(r.y); x[3] = bf_hi(r.y); x[4] = bf_lo(r.z); x[5] = bf_hi(r.z); x[6] = bf_lo(r.w); x[7] = bf_hi(r.w); }
template <int ROWS> __device__ __forceinline__ void load_window(LAS unsigned char* lds, const bf16* PMb, int colbyte, int t_first, int tid) {
    constexpr int N = ROWS * 64, NIT = (N + NTHREADS - 1) / NTHREADS;
    const __amdgpu_buffer_rsrc_t rs = __builtin_amdgcn_make_buffer_rsrc((void*)PMb, 0, (int)((size_t)S * PMW * 2), 0x00020000);
    v4u v[NIT];
#pragma unroll
    for (int q = 0; q < NIT; ++q) { const int i = tid + q * NTHREADS, r = i >> 6, ch = i & 63, t = t_first + r;
        const unsigned off = (i < N && t >= 0) ? (unsigned)t * (unsigned)(PMW * 2) + (unsigned)(colbyte + ch * 16) : 0xFFFFFFF0u;
        v[q] = __builtin_bit_cast(v4u, __builtin_amdgcn_raw_buffer_load_b128(rs, off, 0, 0)); }
#pragma unroll
    for (int q = 0; q < NIT; ++q) { const int i = tid + q * NTHREADS, r = i >> 6, ch = i & 63; if (i < N) *(LAS v4u*)(lds + r * 1024 + ch * 16) = v[q]; }
}
__device__ __forceinline__ void mix_conv_unit(LAS unsigned char* lds, const bf16* PM, bf16* Y, const float* cw, const float* cbias, const float* lng, const float* lnb, int t0, int tid, int lane, int wave) {
    asm volatile("" : "+v"(tid)); lane = tid & 63;
    LAS unsigned* win = (LAS unsigned*)lds;
    LAS float* cout = (LAS float*)(lds + 63488);
    load_window<62>(lds, PM, 0, t0 - 30, tid);
    const int cp = tid & 255, th = tid >> 8;
    f32x2 wk[31];
#pragma unroll
    for (int k = 0; k < 31; ++k) wk[k] = *(const f32x2*)(cw + k * BW + 2 * cp);
    const f32x2 cb = *(const f32x2*)(cbias + 2 * cp);
    __syncthreads();
    for (int blk = 0; blk < 2; ++blk) {
        const int tb = th * 16 + blk * 8;
        f32x2 acc[8];
#pragma unroll
        for (int o = 0; o < 8; ++o) acc[o] = cb;
#pragma unroll
        for (int i = 0; i < 38; ++i) {
            const unsigned wv = win[(tb + i) * 256 + cp]; const f32x2 v = (f32x2){bf_lo(wv), bf_hi(wv)};
#pragma unroll
            for (int o = 0; o < 8; ++o) { const int k = i - o; if (k >= 0 && k <= 30) acc[o] += wk[k] * v; }
            if ((i & 3) == 3) asm volatile("" ::: "memory");
        }
#pragma unroll
        for (int o = 0; o < 8; ++o) *(LAS f32x2*)(cout + (tb + o) * BW + 2 * cp) = acc[o];
    }
    __syncthreads();
    const f32x4 g0 = *(const f32x4*)(lng + lane * 8), g1 = *(const f32x4*)(lng + lane * 8 + 4), b0 = *(const f32x4*)(lnb + lane * 8), b1 = *(const f32x4*)(lnb + lane * 8 + 4);
    { f32x4 a0[4], a1[4]; float sm[4], sq[4];
#pragma unroll
      for (int q = 0; q < 4; ++q) { const int tok = wave * 4 + q; a0[q] = *(const LAS f32x4*)(cout + tok * BW + lane * 8); a1[q] = *(const LAS f32x4*)(cout + tok * BW + lane * 8 + 4);
          sm[q] = (a0[q][0] + a0[q][1]) + (a0[q][2] + a0[q][3]) + (a1[q][0] + a1[q][1]) + (a1[q][2] + a1[q][3]); }
      wave_sum_n<4>(sm);
#pragma unroll
      for (int q = 0; q < 4; ++q) { const float mean = sm[q] * (1.0f / BW); a0[q] = a0[q] - mean; a1[q] = a1[q] - mean;
          sq[q] = (a0[q][0] * a0[q][0] + a0[q][1] * a0[q][1]) + (a0[q][2] * a0[q][2] + a0[q][3] * a0[q][3]) + (a1[q][0] * a1[q][0] + a1[q][1] * a1[q][1]) + (a1[q][2] * a1[q][2] + a1[q][3] * a1[q][3]); }
      wave_sum_n<4>(sq);
#pragma unroll
      for (int q = 0; q < 4; ++q) { const int tok = wave * 4 + q; const float rstd = rsqrtf(sq[q] * (1.0f / BW) + LN_EPS);
          f32x4 y0 = a0[q] * rstd * g0 + b0, y1 = a1[q] * rstd * g1 + b1;
          y0 = y0 * pg8::sigmoid4(y0); y1 = y1 * pg8::sigmoid4(y1);
          *(v4u*)(Y + (size_t)(t0 + tok) * D + lane * 8) = pg8::pack8(y0, y1); } }
    __syncthreads();
}
template <int WN> __device__ __forceinline__ void pool_window(const f32x2 (&xw)[31], f32x2 (&sres)[16]) {
    f32x2 s = (f32x2){0.f, 0.f};
#pragma unroll
    for (int j = 0; j < WN; ++j) s += xw[15 - j];
    sres[0] = s;
#pragma unroll
    for (int o = 1; o < 16; ++o) { s += xw[15 + o] - xw[15 + o - WN]; sres[o] = s; }
}
__device__ __forceinline__ void mix_pool_unit(LAS unsigned char* lds, const bf16* PM, bf16* Y, const bf16* pw, const float* pscale, int t0, int tid, int lane, int wave) {
    asm volatile("" : "+v"(tid)); lane = tid & 63;
    LAS unsigned* pin = (LAS unsigned*)lds;
    LAS unsigned char* pimg = lds + 48128;
    load_window<47>(lds, PM, 1024, t0 - 15, tid);
    __syncthreads();
    { const int cp = tid & 255, th = tid >> 8, grp = cp >> 6;
      f32x2 xw[31];
#pragma unroll
      for (int k = 0; k < 31; ++k) { const unsigned w = pin[(th * 16 + k) * 256 + cp]; xw[k] = (f32x2){bf_lo(w), bf_hi(w)}; }
      f32x2 sres[16];
      if (grp == 0) pool_window<2>(xw, sres); else if (grp == 1) pool_window<4>(xw, sres); else if (grp == 2) pool_window<8>(xw, sres); else pool_window<16>(xw, sres);
      const int wn = 2 << grp;
#pragma unroll
      for (int o = 0; o < 16; ++o) { const int tok = th * 16 + o, tg = t0 + tok; const float cnt = (float)((tg + 1) < wn ? (tg + 1) : wn);
          *(LAS unsigned*)(pimg + tok * 1040 + cp * 4) = pk2(sres[o].x / cnt - xw[15 + o].x, sres[o].y / cnt - xw[15 + o].y); } }
    __syncthreads();
    { const int g2 = wave >> 1, dh = wave & 1, fr = lane & 15, fq = lane >> 4;
      bf16x8 Pf[2][4];
#pragma unroll
      for (int rb = 0; rb < 2; ++rb)
#pragma unroll
          for (int ks = 0; ks < 4; ++ks) Pf[rb][ks] = *(const LAS bf16x8*)(pimg + (rb * 16 + fr) * 1040 + (g2 * 128 + ks * 32 + 8 * fq) * 2);
      bf16x8 Wf[4][4];
#pragma unroll
      for (int cb = 0; cb < 4; ++cb)
#pragma unroll
          for (int ks = 0; ks < 4; ++ks) Wf[cb][ks] = *(const bf16x8*)(pw + (size_t)(g2 * 128 + dh * 64 + cb * 16 + fr) * 128 + ks * 32 + 8 * fq);
      asm volatile("" ::: "memory");
#pragma unroll
      for (int cb = 0; cb < 4; ++cb) { const int d0 = dh * 64 + cb * 16;
          f32x4 a0 = (f32x4){0.f, 0.f, 0.f, 0.f}, a1 = (f32x4){0.f, 0.f, 0.f, 0.f};
#pragma unroll
          for (int ks = 0; ks < 4; ++ks) { a0 = __builtin_amdgcn_mfma_f32_16x16x32_bf16(Wf[cb][ks], Pf[0][ks], a0, 0, 0, 0); a1 = __builtin_amdgcn_mfma_f32_16x16x32_bf16(Wf[cb][ks], Pf[1][ks], a1, 0, 0, 0); }
          const f32x4 sc = *(const f32x4*)(pscale + g2 * 128 + d0 + 4 * fq);
          a0 = a0 * sc; a1 = a1 * sc;
          v2u o0, o1; o0.x = pk2(a0[0], a0[1]); o0.y = pk2(a0[2], a0[3]); o1.x = pk2(a1[0], a1[1]); o1.y = pk2(a1[2], a1[3]);
          *(v2u*)(Y + (size_t)(t0 + fr) * D + 512 + g2 * 128 + d0 + 4 * fq) = o0;
          *(v2u*)(Y + (size_t)(t0 + 16 + fr) * D + 512 + g2 * 128 + d0 + 4 * fq) = o1; } }
    __syncthreads();
}
__device__ __forceinline__ void mix_sgu_unit(LAS unsigned char* lds, const bf16* PM, bf16* Y, const bf16* sw, const float* lng, const float* lnb, const float* bs, int ci, int g, int tid, int lane, int wave) {
    asm volatile("" : "+v"(tid)); lane = tid & 63;
    LAS f32x2* st = (LAS f32x2*)lds;
    LAS unsigned char* vimg = lds + 1024;
    const int t0 = ci * 128;
    v4u raw[16];
#pragma unroll
    for (int q = 0; q < 16; ++q) raw[q] = *(const v4u*)(PM + (size_t)(t0 + wave * 16 + q) * PMW + 1536 + lane * 8);
    { float sm[16], sq[16];
#pragma unroll
      for (int q = 0; q < 16; ++q) { float x[8]; unpack8(raw[q], x); sm[q] = (x[0] + x[1]) + (x[2] + x[3]) + (x[4] + x[5]) + (x[6] + x[7]); }
      wave_sum_n<16>(sm);
#pragma unroll
      for (int q = 0; q < 16; ++q) { float x[8]; unpack8(raw[q], x); const float mean = sm[q] * (1.0f / BW); sm[q] = mean; float q2 = 0.f;
#pragma unroll
          for (int i = 0; i < 8; ++i) { const float d = x[i] - mean; q2 += d * d; }
          sq[q] = q2; }
      wave_sum_n<16>(sq);
#pragma unroll
      for (int q = 0; q < 16; ++q) { const float rstd = rsqrtf(sq[q] * (1.0f / BW) + LN_EPS); if (lane == 0) st[wave * 16 + q] = (f32x2){sm[q], rstd}; } }
    __syncthreads();
    { const int j = tid >> 2, q = tid & 3; const f32x2 ms = st[j];
#pragma unroll
      for (int i = 0; i < 4; ++i) { const int c = 32 * q + 8 * i; float x[8]; unpack8(*(const v4u*)(PM + (size_t)(t0 + j) * PMW + 1536 + g * 128 + c), x);
          const f32x4 g0 = *(const f32x4*)(lng + g * 128 + c), g1 = *(const f32x4*)(lng + g * 128 + c + 4), b0 = *(const f32x4*)(lnb + g * 128 + c), b1 = *(const f32x4*)(lnb + g * 128 + c + 4);
          LAS unsigned* o = (LAS unsigned*)(vimg + j * 260 + c * 2);
          o[0] = pk2((x[0] - ms.x) * ms.y * g0[0] + b0[0], (x[1] - ms.x) * ms.y * g0[1] + b0[1]); o[1] = pk2((x[2] - ms.x) * ms.y * g0[2] + b0[2], (x[3] - ms.x) * ms.y * g0[3] + b0[3]);
          o[2] = pk2((x[4] - ms.x) * ms.y * g1[0] + b1[0], (x[5] - ms.x) * ms.y * g1[1] + b1[1]); o[3] = pk2((x[6] - ms.x) * ms.y * g1[2] + b1[2], (x[7] - ms.x) * ms.y * g1[3] + b1[3]); } }
    __syncthreads();
    { const int c0 = 16 * wave, fr = lane & 15, fq = lane >> 4;
      bf16x8 Xf[4];
#pragma unroll
      for (int ks = 0; ks < 4; ++ks)
#pragma unroll
          for (int e = 0; e < 8; ++e) Xf[ks][e] = *(const LAS short*)(vimg + (ks * 32 + 8 * fq + e) * 260 + (c0 + fr) * 2);
      v2u ur[8]; float bsv[8];
#pragma unroll
      for (int tb = 0; tb < 8; ++tb) { const int t = tb * 16 + fr; bsv[tb] = bs[g * 128 + t]; ur[tb] = *(const v2u*)(PM + (size_t)(t0 + t) * PMW + 1024 + g * 128 + c0 + 4 * fq); }
      bf16x8 Yf[8][4];
#pragma unroll
      for (int tb = 0; tb < 8; ++tb)
#pragma unroll
          for (int ks = 0; ks < 4; ++ks) if (ks <= tb / 2) Yf[tb][ks] = *(const bf16x8*)(sw + (size_t)(g * 128 + tb * 16 + fr) * 128 + ks * 32 + 8 * fq);
      asm volatile("" ::: "memory");
#pragma unroll
      for (int tb = 0; tb < 8; ++tb) { f32x4 acc = (f32x4){0.f, 0.f, 0.f, 0.f};
#pragma unroll
          for (int ks = 0; ks < 4; ++ks) if (ks <= tb / 2) acc = __builtin_amdgcn_mfma_f32_16x16x32_bf16(Xf[ks], Yf[tb][ks], acc, 0, 0, 0);
          const int t = tb * 16 + fr;
          v2u o; o.x = pk2(bf_lo(ur[tb].x) * (acc[0] + bsv[tb]), bf_hi(ur[tb].x) * (acc[1] + bsv[tb])); o.y = pk2(bf_lo(ur[tb].y) * (acc[2] + bsv[tb]), bf_hi(ur[tb].y) * (acc[3] + bsv[tb]));
          *(v2u*)(Y + (size_t)(t0 + t) * D + 1024 + g * 128 + c0 + 4 * fq) = o; } }
    __syncthreads();
}
__device__ __forceinline__ void mix_sconv_unit(const bf16* PM, bf16* Y, const float* sw, int t0, int lane, int wave) {
    asm volatile("" : "+v"(lane));
    const int ch = lane * 8, tb = t0 + wave * 8;
    float w0[8], w1[8], w2[8], xm2[8], xm1[8];
#pragma unroll
    for (int i = 0; i < 8; ++i) { w0[i] = sw[ch + i]; w1[i] = sw[BW + ch + i]; w2[i] = sw[2 * BW + ch + i]; xm2[i] = 0.f; xm1[i] = 0.f; }
    if (tb >= 2) { unpack8(*(const v4u*)(PM + (size_t)(tb - 2) * PMW + 2560 + ch), xm2); }
    if (tb >= 1) { unpack8(*(const v4u*)(PM + (size_t)(tb - 1) * PMW + 2560 + ch), xm1); }
#pragma unroll
    for (int i = 0; i < 8; ++i) { const int t = tb + i; float x[8], gb[8], y[8];
        unpack8(*(const v4u*)(PM + (size_t)t * PMW + 2560 + ch), x); unpack8(*(const v4u*)(PM + (size_t)t * PMW + 2048 + ch), gb);
#pragma unroll
        for (int e = 0; e < 8; ++e) { y[e] = gb[e] * (w0[e] * xm2[e] + w1[e] * xm1[e] + w2[e] * x[e]); xm2[e] = xm1[e]; xm1[e] = x[e]; }
        v4u o; o.x = pk2(y[0], y[1]); o.y = pk2(y[2], y[3]); o.z = pk2(y[4], y[5]); o.w = pk2(y[6], y[7]);
        *(v4u*)(Y + (size_t)t * D + 1536 + ch) = o; }
}

__global__ void __launch_bounds__(NTHREADS, 2) fwd_kernel(Args args) {
    extern __shared__ __attribute__((aligned(16))) unsigned char lds_raw[];
    LAS unsigned char* lds = (LAS unsigned char*)lds_raw;
    volatile LAS unsigned* MISC = (volatile LAS unsigned*)(lds + MISC_OFF);
    const int tid = threadIdx.x, lane = tid & 63, wave = __builtin_amdgcn_readfirstlane(tid >> 6);
    const int G = gridDim.x, bx = blockIdx.x, vcu = (G % 8 == 0) ? (bx % 8) * (G / 8) + bx / 8 : bx;
    const int gw = vcu * NWAVES + wave, NGW = G * NWAVES;
    gu32* ctl; int lo, hi; { const KArgs ap = kargs(); ctl = (gu32*)(ap->ws + WS_CTL); lo = ap->ph_lo; hi = ap->ph_hi; }
    for (int u = tid; u < (LDS_BYTES - LDSCTL_OFF) / 4; u += NTHREADS) ((LAS unsigned*)(lds + LDSCTL_OFF))[u] = 0u;
    __syncthreads();
    XcdBarrier bar; bar.bar = (unsigned*)(ctl + CW_BAR); bar.x = 0; bar.st = nullptr;
    if (!MK_PER_PHASE) bar = xcd_barrier_post((unsigned*)(ctl + CW_BAR), MISC + 8);
#define GRID_BAR() do { if (MK_PER_PHASE) { if (tid == 0) __hip_atomic_store(ctl + CW_TMO, 0xBADBA0u, RLX_AGENT); } else { XcdBarrier b2_ = bar; asm volatile("" : "+s"(b2_.bar), "+s"(b2_.x)); xcd_barrier(b2_); } } while (0)
#ifndef PH_MASK
#define PH_MASK 0xff
#endif
#define PHEN(t) (((PH_MASK) >> (t)) & 1)
#ifndef REP_MASK
#define REP_MASK 0
#endif
#define NREP(t) (1 + (((REP_MASK) >> (t)) & 1))
#ifndef MIX_MASK
#define MIX_MASK 0xf
#endif
#define MIXEN(t) (((MIX_MASK) >> (t)) & 1)
#define IN(k) (lo <= (k) && (k) < hi)
#ifndef BAR_REP
#define BAR_REP 1
#endif
#define SEAM(k) do { if (IN((k) + 1)) { for (int br_ = 0; br_ < BAR_REP; ++br_) GRID_BAR(); } } while (0)

    if (PHEN(0) && IN(0)) {
        const KArgs ap = kargs();
        LAS unsigned* scr = (LAS unsigned*)(lds + RING_OFF + wave * 8448);
        for (int rep = 0; rep < NREP(0); ++rep) {
            for (int it = gw; it < N_ADA_ITEMS; it += NGW) p0_ada_item(ap, it, lane);
            constexpr int NCONV = NL * CONV_ITEMS_PER_LAYER;
            int ci = NGW - 1 - gw;
            if (ci < NCONV) {
                TrJob cur = p0_conv_job(ap, ci); f32x4 v[8][2]; tr_load(cur, v, lane);
                for (;;) {
                    const int cn = ci + NGW; const bool has = cn < NCONV; TrJob nx = cur; f32x4 w[8][2];
                    if (has) { nx = p0_conv_job(ap, cn); tr_load(nx, w, lane); }
                    tr_finish(cur, v, scr, lane);
                    if (!has) break;
                    cur = nx; ci = cn;
#pragma unroll
                    for (int jp = 0; jp < 8; ++jp) { v[jp][0] = w[jp][0]; v[jp][1] = w[jp][1]; }
                }
            }
            for (int it = gw; it < N_SGU_ITEMS; it += NGW) p0_sgu_item(ap, it, lane);
        }
        SEAM(0);
    }
    if (PHEN(1) && IN(1)) {
        const KArgs ap = kargs(); unsigned char* ws = ap->ws; const float* x_in = ap->in[0]; float* xres = ap->out; const float* adap = (const float*)(ws + WS_ADAP); const float* ada_b = ap->in[3];
        bf16* NBUF = (bf16*)(ws + WS_NBUF); bf16* ACT = (bf16*)(ws + WS_ACT); bf16* Z = (bf16*)(ws + WS_Z); bf16* PM = (bf16*)(ws + WS_PM); bf16* GB = (bf16*)(ws + WS_G); bf16* YB = (bf16*)(ws + WS_Y); bf16* MG = (bf16*)(ws + WS_MG); bf16* XB = (bf16*)(ws + WS_XB); (void)XB;
        (void)x_in; (void)xres; (void)adap; (void)ada_b; (void)NBUF; (void)ACT; (void)Z; (void)PM; (void)GB; (void)YB; (void)MG;
        resnorm_phase<false, true, true, false>(lds, x_in, nullptr, nullptr, NBUF, adap, ada_b, nullptr, 0, 0.f, ap->in[4], 0, gw, NGW, tid, lane);
        SEAM(1);
    }
    for (int l = 0; l < NL; ++l) {
        const int pb = 2 + 11 * l;
        if (PHEN(2) && IN(pb + 0)) {
            const KArgs ap = kargs(); unsigned char* ws = ap->ws; const float* x_in = ap->in[0]; float* xres = ap->out; const float* adap = (const float*)(ws + WS_ADAP); const float* ada_b = ap->in[3];
            bf16* NBUF = (bf16*)(ws + WS_NBUF); bf16* ACT = (bf16*)(ws + WS_ACT); bf16* Z = (bf16*)(ws + WS_Z); bf16* PM = (bf16*)(ws + WS_PM); bf16* GB = (bf16*)(ws + WS_G); bf16* YB = (bf16*)(ws + WS_Y); bf16* MG = (bf16*)(ws + WS_MG); bf16* XB = (bf16*)(ws + WS_XB); (void)XB;
            (void)x_in; (void)xres; (void)adap; (void)ada_b; (void)NBUF; (void)ACT; (void)Z; (void)PM; (void)GB; (void)YB; (void)MG;
            int lp = l; asm volatile("" : "+s"(lp));
            const bf16* WIN0 = (const bf16*)(ws + WS_WIN) + (size_t)(lp * 2) * 2 * FF * D; const bf16* WOUT0 = (const bf16*)(ws + WS_WOUT) + (size_t)(lp * 2) * D * FF;
            const bf16* WMIX = (const bf16*)(ws + WS_WMIX) + (size_t)lp * NMIXG * D; const bf16* WBR = (const bf16*)(ws + WS_WBR) + (size_t)lp * D * 2048; const bf16* WO = (const bf16*)(ws + WS_WO) + (size_t)lp * D * D;
            (void)WIN0; (void)WOUT0; (void)WMIX; (void)WBR; (void)WO;
            pg8::Gemm g{NBUF, WIN0, S, 2 * FF, D}; pg8::StaticOrder So; So.init(S, 2 * FF, G, bx);
            pg8::EpiSwiGLU E{ACT, FF};
            for (int rep = 0; rep < NREP(2); ++rep) pg8::gemm_phase<pg8::EpiSwiGLU, pg8::StaticOrder, PG8_ALIGN, PG8_SP2>(lds + RING_OFF, g, So, E);
            SEAM(pb + 0);
        }
        if (PHEN(3) && IN(pb + 1)) {
            const KArgs ap = kargs(); unsigned char* ws = ap->ws; const float* x_in = ap->in[0]; float* xres = ap->out; const float* adap = (const float*)(ws + WS_ADAP); const float* ada_b = ap->in[3];
            bf16* NBUF = (bf16*)(ws + WS_NBUF); bf16* ACT = (bf16*)(ws + WS_ACT); bf16* Z = (bf16*)(ws + WS_Z); bf16* PM = (bf16*)(ws + WS_PM); bf16* GB = (bf16*)(ws + WS_G); bf16* YB = (bf16*)(ws + WS_Y); bf16* MG = (bf16*)(ws + WS_MG); bf16* XB = (bf16*)(ws + WS_XB); (void)XB;
            (void)x_in; (void)xres; (void)adap; (void)ada_b; (void)NBUF; (void)ACT; (void)Z; (void)PM; (void)GB; (void)YB; (void)MG;
            int lp = l; asm volatile("" : "+s"(lp));
            const bf16* WIN0 = (const bf16*)(ws + WS_WIN) + (size_t)(lp * 2) * 2 * FF * D; const bf16* WOUT0 = (const bf16*)(ws + WS_WOUT) + (size_t)(lp * 2) * D * FF;
            const bf16* WMIX = (const bf16*)(ws + WS_WMIX) + (size_t)lp * NMIXG * D; const bf16* WBR = (const bf16*)(ws + WS_WBR) + (size_t)lp * D * 2048; const bf16* WO = (const bf16*)(ws + WS_WO) + (size_t)lp * D * D;
            (void)WIN0; (void)WOUT0; (void)WMIX; (void)WBR; (void)WO;
            pg8::Gemm g{ACT, WOUT0, S, D, FF}; pg8::StaticOrder So; So.init(S, D, G, bx);
            pg8::EpiBf16Plain E{Z, D};
            for (int rep = 0; rep < NREP(3); ++rep) pg8::gemm_phase<pg8::EpiBf16Plain, pg8::StaticOrder, PG8_ALIGN, PG8_SP2>(lds + RING_OFF, g, So, E);
            SEAM(pb + 1);
        }
        if (PHEN(1) && IN(pb + 2)) {
            const KArgs ap = kargs(); unsigned char* ws = ap->ws; const float* x_in = ap->in[0]; float* xres = ap->out; const float* adap = (const float*)(ws + WS_ADAP); const float* ada_b = ap->in[3];
            bf16* NBUF = (bf16*)(ws + WS_NBUF); bf16* ACT = (bf16*)(ws + WS_ACT); bf16* Z = (bf16*)(ws + WS_Z); bf16* PM = (bf16*)(ws + WS_PM); bf16* GB = (bf16*)(ws + WS_G); bf16* YB = (bf16*)(ws + WS_Y); bf16* MG = (bf16*)(ws + WS_MG); bf16* XB = (bf16*)(ws + WS_XB); (void)XB;
            (void)x_in; (void)xres; (void)adap; (void)ada_b; (void)NBUF; (void)ACT; (void)Z; (void)PM; (void)GB; (void)YB; (void)MG;
            int lp = l; asm volatile("" : "+s"(lp));
            const bf16* WIN0 = (const bf16*)(ws + WS_WIN) + (size_t)(lp * 2) * 2 * FF * D; const bf16* WOUT0 = (const bf16*)(ws + WS_WOUT) + (size_t)(lp * 2) * D * FF;
            const bf16* WMIX = (const bf16*)(ws + WS_WMIX) + (size_t)lp * NMIXG * D; const bf16* WBR = (const bf16*)(ws + WS_WBR) + (size_t)lp * D * 2048; const bf16* WO = (const bf16*)(ws + WS_WO) + (size_t)lp * D * D;
            (void)WIN0; (void)WOUT0; (void)WMIX; (void)WBR; (void)WO;
            if (lp == 0) resnorm_phase<true, true, true, false>(lds, x_in, XB, Z, NBUF, adap, ada_b, ap->in[5] + (size_t)(lp * 3 + 0) * D, lp * NADA + (0 * 3 + 2) * D, 0.5f,
                                      ap->in[4] + (size_t)(lp * 3 + 1) * D, lp * NADA + (1 * 3) * D, gw, NGW, tid, lane);
            else resnorm_phase<true, true, false, false>(lds, XB, XB, Z, NBUF, adap, ada_b, ap->in[5] + (size_t)(lp * 3 + 0) * D, lp * NADA + (0 * 3 + 2) * D, 0.5f,
                                      ap->in[4] + (size_t)(lp * 3 + 1) * D, lp * NADA + (1 * 3) * D, gw, NGW, tid, lane);
            SEAM(pb + 2);
        }
        if (PHEN(4) && IN(pb + 3)) {
            const KArgs ap = kargs(); unsigned char* ws = ap->ws; const float* x_in = ap->in[0]; float* xres = ap->out; const float* adap = (const float*)(ws + WS_ADAP); const float* ada_b = ap->in[3];
            bf16* NBUF = (bf16*)(ws + WS_NBUF); bf16* ACT = (bf16*)(ws + WS_ACT); bf16* Z = (bf16*)(ws + WS_Z); bf16* PM = (bf16*)(ws + WS_PM); bf16* GB = (bf16*)(ws + WS_G); bf16* YB = (bf16*)(ws + WS_Y); bf16* MG = (bf16*)(ws + WS_MG); bf16* XB = (bf16*)(ws + WS_XB); (void)XB;
            (void)x_in; (void)xres; (void)adap; (void)ada_b; (void)NBUF; (void)ACT; (void)Z; (void)PM; (void)GB; (void)YB; (void)MG;
            int lp = l; asm volatile("" : "+s"(lp));
            const bf16* WIN0 = (const bf16*)(ws + WS_WIN) + (size_t)(lp * 2) * 2 * FF * D; const bf16* WOUT0 = (const bf16*)(ws + WS_WOUT) + (size_t)(lp * 2) * D * FF;
            const bf16* WMIX = (const bf16*)(ws + WS_WMIX) + (size_t)lp * NMIXG * D; const bf16* WBR = (const bf16*)(ws + WS_WBR) + (size_t)lp * D * 2048; const bf16* WO = (const bf16*)(ws + WS_WO) + (size_t)lp * D * D;
            (void)WIN0; (void)WOUT0; (void)WMIX; (void)WBR; (void)WO;
            pg8::Gemm g{NBUF, WMIX, S, 4096, D}; pg8::StaticOrder So; So.init(S, 4096, G, bx);
            pg8::EpiMix E{PM, GB, ap->in[10] + (size_t)lp * 4 * D, 0};
            for (int rep = 0; rep < NREP(4); ++rep) pg8::gemm_phase<pg8::EpiMix, pg8::StaticOrder, PG8_ALIGN, PG8_SP2>(lds + RING_OFF, g, So, E);
            SEAM(pb + 3);
        }
        if (PHEN(5) && IN(pb + 4)) {
            const KArgs ap = kargs(); unsigned char* ws = ap->ws; const float* x_in = ap->in[0]; float* xres = ap->out; const float* adap = (const float*)(ws + WS_ADAP); const float* ada_b = ap->in[3];
            bf16* NBUF = (bf16*)(ws + WS_NBUF); bf16* ACT = (bf16*)(ws + WS_ACT); bf16* Z = (bf16*)(ws + WS_Z); bf16* PM = (bf16*)(ws + WS_PM); bf16* GB = (bf16*)(ws + WS_G); bf16* YB = (bf16*)(ws + WS_Y); bf16* MG = (bf16*)(ws + WS_MG); bf16* XB = (bf16*)(ws + WS_XB); (void)XB;
            (void)x_in; (void)xres; (void)adap; (void)ada_b; (void)NBUF; (void)ACT; (void)Z; (void)PM; (void)GB; (void)YB; (void)MG;
            int lp = l; asm volatile("" : "+s"(lp));
            const bf16* WIN0 = (const bf16*)(ws + WS_WIN) + (size_t)(lp * 2) * 2 * FF * D; const bf16* WOUT0 = (const bf16*)(ws + WS_WOUT) + (size_t)(lp * 2) * D * FF;
            const bf16* WMIX = (const bf16*)(ws + WS_WMIX) + (size_t)lp * NMIXG * D; const bf16* WBR = (const bf16*)(ws + WS_WBR) + (size_t)lp * D * 2048; const bf16* WO = (const bf16*)(ws + WS_WO) + (size_t)lp * D * D;
            (void)WIN0; (void)WOUT0; (void)WMIX; (void)WBR; (void)WO;
            {
            int wv = wave, vc = vcu; asm volatile("" : "+s"(wv), "+s"(vc));
            if (MIXEN(0)) for (int i = 0; i < 2 * NREP(5); ++i) { const int u = vc + G * (i & 1); if (u < S / 32)
                mix_conv_unit(lds, PM, YB, ap->in[11] + (size_t)lp * 31 * BW, ap->in[12] + (size_t)lp * BW, ap->in[13] + (size_t)lp * BW, ap->in[14] + (size_t)lp * BW, 32 * u, tid, lane, wv); }
            if (MIXEN(1)) for (int i = 0; i < 2 * NREP(5); ++i) { const int u = vc + G * (i & 1); if (u < S / 32)
                mix_pool_unit(lds, PM, YB, (const bf16*)(ws + WS_POOLW) + (size_t)lp * 4 * 128 * 128, ap->in[16] + (size_t)lp * BW, 32 * u, tid, lane, wv); }
            if (MIXEN(2)) for (int i = 0; i < 2 * NREP(5); ++i) { const int u = vc + G * (i & 1); if (u < (S / 128) * 4)
                mix_sgu_unit(lds, PM, YB, (const bf16*)(ws + WS_SGUW) + (size_t)lp * 4 * 128 * 128, ap->in[17] + (size_t)lp * BW, ap->in[18] + (size_t)lp * BW, ap->in[20] + (size_t)lp * 4 * 128, u >> 2, u & 3, tid, lane, wv); }
            if (MIXEN(3)) for (int i = 0; i < NREP(5); ++i) { const int u = vc; if (u < S / 64) mix_sconv_unit(PM, YB, ap->in[21] + (size_t)lp * 3 * BW, 64 * u, lane, wv); }
            }
            __syncthreads();
            { pg8::Gemm g{NBUF, WMIX + (size_t)4096 * D, S, 8192, D}; pg8::StaticOrder So; So.init(S, 8192, G, bx);
              pg8::EpiMix E{PM, GB, ap->in[10] + (size_t)lp * 4 * D, 16};
              pg8::gemm_phase<pg8::EpiMix, pg8::StaticOrder, PG8_ALIGN, PG8_SP2>(lds + RING_OFF, g, So, E); }
            SEAM(pb + 4);
        }
        if (PHEN(6) && IN(pb + 5)) {
            const KArgs ap = kargs(); unsigned char* ws = ap->ws; const float* x_in = ap->in[0]; float* xres = ap->out; const float* adap = (const float*)(ws + WS_ADAP); const float* ada_b = ap->in[3];
            bf16* NBUF = (bf16*)(ws + WS_NBUF); bf16* ACT = (bf16*)(ws + WS_ACT); bf16* Z = (bf16*)(ws + WS_Z); bf16* PM = (bf16*)(ws + WS_PM); bf16* GB = (bf16*)(ws + WS_G); bf16* YB = (bf16*)(ws + WS_Y); bf16* MG = (bf16*)(ws + WS_MG); bf16* XB = (bf16*)(ws + WS_XB); (void)XB;
            (void)x_in; (void)xres; (void)adap; (void)ada_b; (void)NBUF; (void)ACT; (void)Z; (void)PM; (void)GB; (void)YB; (void)MG;
            int lp = l; asm volatile("" : "+s"(lp));
            const bf16* WIN0 = (const bf16*)(ws + WS_WIN) + (size_t)(lp * 2) * 2 * FF * D; const bf16* WOUT0 = (const bf16*)(ws + WS_WOUT) + (size_t)(lp * 2) * D * FF;
            const bf16* WMIX = (const bf16*)(ws + WS_WMIX) + (size_t)lp * NMIXG * D; const bf16* WBR = (const bf16*)(ws + WS_WBR) + (size_t)lp * D * 2048; const bf16* WO = (const bf16*)(ws + WS_WO) + (size_t)lp * D * D;
            (void)WIN0; (void)WOUT0; (void)WMIX; (void)WBR; (void)WO;
            pg8::StaticOrder So; So.init(S, D, G, bx, 256, 128);
            for (int rep = 0; rep < NREP(6); ++rep) pg8::gated_merge3_phase<pg8::StaticOrder>(lds + RING_OFF, YB, WBR, GB, MG, So);
            SEAM(pb + 5);
        }
        if (PHEN(3) && IN(pb + 6)) {
            const KArgs ap = kargs(); unsigned char* ws = ap->ws; const float* x_in = ap->in[0]; float* xres = ap->out; const float* adap = (const float*)(ws + WS_ADAP); const float* ada_b = ap->in[3];
            bf16* NBUF = (bf16*)(ws + WS_NBUF); bf16* ACT = (bf16*)(ws + WS_ACT); bf16* Z = (bf16*)(ws + WS_Z); bf16* PM = (bf16*)(ws + WS_PM); bf16* GB = (bf16*)(ws + WS_G); bf16* YB = (bf16*)(ws + WS_Y); bf16* MG = (bf16*)(ws + WS_MG); bf16* XB = (bf16*)(ws + WS_XB); (void)XB;
            (void)x_in; (void)xres; (void)adap; (void)ada_b; (void)NBUF; (void)ACT; (void)Z; (void)PM; (void)GB; (void)YB; (void)MG;
            int lp = l; asm volatile("" : "+s"(lp));
            const bf16* WIN0 = (const bf16*)(ws + WS_WIN) + (size_t)(lp * 2) * 2 * FF * D; const bf16* WOUT0 = (const bf16*)(ws + WS_WOUT) + (size_t)(lp * 2) * D * FF;
            const bf16* WMIX = (const bf16*)(ws + WS_WMIX) + (size_t)lp * NMIXG * D; const bf16* WBR = (const bf16*)(ws + WS_WBR) + (size_t)lp * D * 2048; const bf16* WO = (const bf16*)(ws + WS_WO) + (size_t)lp * D * D;
            (void)WIN0; (void)WOUT0; (void)WMIX; (void)WBR; (void)WO;
            pg8::Gemm g{MG, WO, S, D, D}; pg8::StaticOrder So; So.init(S, D, G, bx);
            pg8::EpiBf16Plain E{Z, D};
            for (int rep = 0; rep < NREP(7); ++rep) pg8::gemm_phase<pg8::EpiBf16Plain, pg8::StaticOrder, PG8_ALIGN, PG8_SP2>(lds + RING_OFF, g, So, E);
            SEAM(pb + 6);
        }
        if (PHEN(1) && IN(pb + 7)) {
            const KArgs ap = kargs(); unsigned char* ws = ap->ws; const float* x_in = ap->in[0]; float* xres = ap->out; const float* adap = (const float*)(ws + WS_ADAP); const float* ada_b = ap->in[3];
            bf16* NBUF = (bf16*)(ws + WS_NBUF); bf16* ACT = (bf16*)(ws + WS_ACT); bf16* Z = (bf16*)(ws + WS_Z); bf16* PM = (bf16*)(ws + WS_PM); bf16* GB = (bf16*)(ws + WS_G); bf16* YB = (bf16*)(ws + WS_Y); bf16* MG = (bf16*)(ws + WS_MG); bf16* XB = (bf16*)(ws + WS_XB); (void)XB;
            (void)x_in; (void)xres; (void)adap; (void)ada_b; (void)NBUF; (void)ACT; (void)Z; (void)PM; (void)GB; (void)YB; (void)MG;
            int lp = l; asm volatile("" : "+s"(lp));
            const bf16* WIN0 = (const bf16*)(ws + WS_WIN) + (size_t)(lp * 2) * 2 * FF * D; const bf16* WOUT0 = (const bf16*)(ws + WS_WOUT) + (size_t)(lp * 2) * D * FF;
            const bf16* WMIX = (const bf16*)(ws + WS_WMIX) + (size_t)lp * NMIXG * D; const bf16* WBR = (const bf16*)(ws + WS_WBR) + (size_t)lp * D * 2048; const bf16* WO = (const bf16*)(ws + WS_WO) + (size_t)lp * D * D;
            (void)WIN0; (void)WOUT0; (void)WMIX; (void)WBR; (void)WO;
            resnorm_phase<true, true, false, false>(lds, XB, XB, Z, NBUF, adap, ada_b, ap->in[5] + (size_t)(lp * 3 + 1) * D, lp * NADA + (1 * 3 + 2) * D, 1.0f,
                                      ap->in[4] + (size_t)(lp * 3 + 2) * D, lp * NADA + (2 * 3) * D, gw, NGW, tid, lane);
            SEAM(pb + 7);
        }
        if (PHEN(2) && IN(pb + 8)) {
            const KArgs ap = kargs(); unsigned char* ws = ap->ws; const float* x_in = ap->in[0]; float* xres = ap->out; const float* adap = (const float*)(ws + WS_ADAP); const float* ada_b = ap->in[3];
            bf16* NBUF = (bf16*)(ws + WS_NBUF); bf16* ACT = (bf16*)(ws + WS_ACT); bf16* Z = (bf16*)(ws + WS_Z); bf16* PM = (bf16*)(ws + WS_PM); bf16* GB = (bf16*)(ws + WS_G); bf16* YB = (bf16*)(ws + WS_Y); bf16* MG = (bf16*)(ws + WS_MG); bf16* XB = (bf16*)(ws + WS_XB); (void)XB;
            (void)x_in; (void)xres; (void)adap; (void)ada_b; (void)NBUF; (void)ACT; (void)Z; (void)PM; (void)GB; (void)YB; (void)MG;
            int lp = l; asm volatile("" : "+s"(lp));
            const bf16* WIN0 = (const bf16*)(ws + WS_WIN) + (size_t)(lp * 2) * 2 * FF * D; const bf16* WOUT0 = (const bf16*)(ws + WS_WOUT) + (size_t)(lp * 2) * D * FF;
            const bf16* WMIX = (const bf16*)(ws + WS_WMIX) + (size_t)lp * NMIXG * D; const bf16* WBR = (const bf16*)(ws + WS_WBR) + (size_t)lp * D * 2048; const bf16* WO = (const bf16*)(ws + WS_WO) + (size_t)lp * D * D;
            (void)WIN0; (void)WOUT0; (void)WMIX; (void)WBR; (void)WO;
            pg8::Gemm g{NBUF, WIN0 + (size_t)2 * FF * D, S, 2 * FF, D}; pg8::StaticOrder So; So.init(S, 2 * FF, G, bx);
            pg8::EpiSwiGLU E{ACT, FF};
            for (int rep = 0; rep < NREP(2); ++rep) pg8::gemm_phase<pg8::EpiSwiGLU, pg8::StaticOrder, PG8_ALIGN, PG8_SP2>(lds + RING_OFF, g, So, E);
            SEAM(pb + 8);
        }
        if (PHEN(3) && IN(pb + 9)) {
            const KArgs ap = kargs(); unsigned char* ws = ap->ws; const float* x_in = ap->in[0]; float* xres = ap->out; const float* adap = (const float*)(ws + WS_ADAP); const float* ada_b = ap->in[3];
            bf16* NBUF = (bf16*)(ws + WS_NBUF); bf16* ACT = (bf16*)(ws + WS_ACT); bf16* Z = (bf16*)(ws + WS_Z); bf16* PM = (bf16*)(ws + WS_PM); bf16* GB = (bf16*)(ws + WS_G); bf16* YB = (bf16*)(ws + WS_Y); bf16* MG = (bf16*)(ws + WS_MG); bf16* XB = (bf16*)(ws + WS_XB); (void)XB;
            (void)x_in; (void)xres; (void)adap; (void)ada_b; (void)NBUF; (void)ACT; (void)Z; (void)PM; (void)GB; (void)YB; (void)MG;
            int lp = l; asm volatile("" : "+s"(lp));
            const bf16* WIN0 = (const bf16*)(ws + WS_WIN) + (size_t)(lp * 2) * 2 * FF * D; const bf16* WOUT0 = (const bf16*)(ws + WS_WOUT) + (size_t)(lp * 2) * D * FF;
            const bf16* WMIX = (const bf16*)(ws + WS_WMIX) + (size_t)lp * NMIXG * D; const bf16* WBR = (const bf16*)(ws + WS_WBR) + (size_t)lp * D * 2048; const bf16* WO = (const bf16*)(ws + WS_WO) + (size_t)lp * D * D;
            (void)WIN0; (void)WOUT0; (void)WMIX; (void)WBR; (void)WO;
            pg8::Gemm g{ACT, WOUT0 + (size_t)D * FF, S, D, FF}; pg8::StaticOrder So; So.init(S, D, G, bx);
            pg8::EpiBf16Plain E{Z, D};
            for (int rep = 0; rep < NREP(3); ++rep) pg8::gemm_phase<pg8::EpiBf16Plain, pg8::StaticOrder, PG8_ALIGN, PG8_SP2>(lds + RING_OFF, g, So, E);
            SEAM(pb + 9);
        }
        if (PHEN(1) && IN(pb + 10)) {
            const KArgs ap = kargs(); unsigned char* ws = ap->ws; const float* x_in = ap->in[0]; float* xres = ap->out; const float* adap = (const float*)(ws + WS_ADAP); const float* ada_b = ap->in[3];
            bf16* NBUF = (bf16*)(ws + WS_NBUF); bf16* ACT = (bf16*)(ws + WS_ACT); bf16* Z = (bf16*)(ws + WS_Z); bf16* PM = (bf16*)(ws + WS_PM); bf16* GB = (bf16*)(ws + WS_G); bf16* YB = (bf16*)(ws + WS_Y); bf16* MG = (bf16*)(ws + WS_MG); bf16* XB = (bf16*)(ws + WS_XB); (void)XB;
            (void)x_in; (void)xres; (void)adap; (void)ada_b; (void)NBUF; (void)ACT; (void)Z; (void)PM; (void)GB; (void)YB; (void)MG;
            int lp = l; asm volatile("" : "+s"(lp));
            const bf16* WIN0 = (const bf16*)(ws + WS_WIN) + (size_t)(lp * 2) * 2 * FF * D; const bf16* WOUT0 = (const bf16*)(ws + WS_WOUT) + (size_t)(lp * 2) * D * FF;
            const bf16* WMIX = (const bf16*)(ws + WS_WMIX) + (size_t)lp * NMIXG * D; const bf16* WBR = (const bf16*)(ws + WS_WBR) + (size_t)lp * D * 2048; const bf16* WO = (const bf16*)(ws + WS_WO) + (size_t)lp * D * D;
            (void)WIN0; (void)WOUT0; (void)WMIX; (void)WBR; (void)WO;
            if (lp + 1 < NL)
                resnorm_phase<true, true, false, false>(lds, XB, XB, Z, NBUF, adap, ada_b, ap->in[5] + (size_t)(lp * 3 + 2) * D, lp * NADA + (2 * 3 + 2) * D, 0.5f,
                                          ap->in[4] + (size_t)((lp + 1) * 3 + 0) * D, (lp + 1) * NADA, gw, NGW, tid, lane);
            else
                resnorm_phase<true, false, false, true>(lds, XB, xres, Z, NBUF, adap, ada_b, ap->in[5] + (size_t)(lp * 3 + 2) * D, lp * NADA + (2 * 3 + 2) * D, 0.5f,
                                           nullptr, 0, gw, NGW, tid, lane);
            SEAM(pb + 10);
        }
    }
#undef IN
#undef SEAM
#undef GRID_BAR
}


extern "C" void kernel_launch(void* const* d_in, const int* in_sizes, int n_in, void* d_out, int out_size, void* d_ws, size_t ws_size, hipStream_t stream) {
    static int grid = 0;
    if (grid == 0) {
        if (n_in != 24 || in_sizes[0] != S * D || out_size != S * D || ws_size < WS_END) { fprintf(stderr, "kernel_launch: unexpected shapes (n_in %d, in0 %d, out %d, ws %zu < %zu); nothing launched\n", n_in, n_in > 0 ? in_sizes[0] : -1, out_size, ws_size, (size_t)WS_END); grid = -1; return; }
        int dev = 0, cus = 0, per_cu = 0;
        if (hipGetDevice(&dev) != hipSuccess || hipDeviceGetAttribute(&cus, hipDeviceAttributeMultiprocessorCount, dev) != hipSuccess) { fprintf(stderr, "kernel_launch: device query failed\n"); grid = -1; return; }
        if (hipFuncSetAttribute((const void*)fwd_kernel, hipFuncAttributeMaxDynamicSharedMemorySize, LDS_BYTES) != hipSuccess) { fprintf(stderr, "kernel_launch: hipFuncSetAttribute failed\n"); grid = -1; return; }
        if (hipOccupancyMaxActiveBlocksPerMultiprocessor(&per_cu, (const void*)fwd_kernel, NTHREADS, LDS_BYTES) != hipSuccess || per_cu < 1) { fprintf(stderr, "kernel_launch: occupancy query reports %d workgroups per CU\n", per_cu); per_cu = 1; }
        (void)hipGetLastError();
        grid = cus;
        if (grid % 8 != 0 || grid <= 0) { fprintf(stderr, "kernel_launch: unexpected CU count %d\n", cus); }
    }
    if (grid < 0) return;
    if (hipMemsetAsync((char*)d_ws + WS_CTL, 0, CTL_ZERO_BYTES, stream) != hipSuccess) { fprintf(stderr, "kernel_launch: memset failed\n"); return; }
    Args a{};
    for (int i = 0; i < 24; ++i) a.in[i] = (const float*)d_in[i];
    a.out = (float*)d_out; a.ws = (unsigned char*)d_ws;
#if MK_PER_PHASE
    for (int ph = 0; ph < NPHASES; ++ph) { a.ph_lo = ph; a.ph_hi = ph + 1; hipLaunchKernelGGL(fwd_kernel, dim3(grid), dim3(NTHREADS), LDS_BYTES, stream, a); }
#else
    a.ph_lo = 0; a.ph_hi = NPHASES;
    hipLaunchKernelGGL(fwd_kernel, dim3(grid), dim3(NTHREADS), LDS_BYTES, stream, a);
#endif
    const hipError_t le = hipPeekAtLastError();
    if (le != hipSuccess) fprintf(stderr, "kernel_launch: launch failed: %s\n", hipGetErrorName(le));
}
```

```cpp
#include <hip/hip_runtime.h>
#include <cstdio>
#include <cstdint>

namespace pg8 {
#define PG8_LAS __attribute__((address_space(3)))
typedef unsigned short bf16_t;
typedef short bf16x8 __attribute__((ext_vector_type(8)));
typedef float f32x4 __attribute__((ext_vector_type(4)));
typedef float f32x2 __attribute__((ext_vector_type(2)));
typedef unsigned u32x4 __attribute__((ext_vector_type(4)));
typedef unsigned u32x2 __attribute__((ext_vector_type(2)));
constexpr int BM = 256, BK = 64, HALF = 128, HTB = HALF * BK * 2  , STAGE_BYTES = 8 * HTB, NXCD = 8, WGM = 8;

__host__ __device__ __forceinline__ int lds_byte(int r, int c) { const int st = (r >> 4) * 2 + (c >> 5), rr = r & 15, cc = c & 31, ob = rr * 64 + cc * 2; return st * 1024 + (ob ^ (((ob >> 9) & 1) << 5)); }
__host__ __device__ __forceinline__ void stage_rc(int b, int& R, int& C) { const int st = b / 1024, sb = b % 1024, swz = sb ^ (((sb >> 9) & 1) << 5); R = (st >> 1) * 16 + swz / 64; C = (st & 1) * 32 + (swz % 64) / 2; }
__host__ __device__ __forceinline__ int perm32(int rho) { const int n = rho >> 4, i = rho & 15; return 8 * (i >> 2) + 4 * n + (i & 3); }

struct Unit { int pm, pn; };
struct Gemm { const bf16_t* A; const bf16_t* Bt; int M, N, K; };

struct StaticOrder {
    int nM, nN, nwg, G, c;
    __host__ __device__ void init(int M, int N, int G_, int c_, int bn = BM, int bm = BM) { nM = M / bm; nN = N / bn; nwg = nM * nN; G = G_; c = c_; }
    __host__ __device__ bool next(int i, Unit& u) const {
        const long L = (long)i * G + c; if (L >= nwg) return false;
        int wgid = (int)L; { const int q = nwg / NXCD, r = nwg % NXCD, xcd = wgid % NXCD, off = wgid / NXCD; wgid = (xcd < r ? xcd * (q + 1) : r * (q + 1) + (xcd - r) * q) + off; }
        const int nig = WGM * nN, gid = wgid / nig, fm = gid * WGM, gsz = (nM - fm) < WGM ? (nM - fm) : WGM;
        u.pm = fm + ((wgid % nig) % gsz); u.pn = (wgid % nig) / gsz; return true;
    }
    __device__ __forceinline__ void a_ready(const Unit&) const {}
    __device__ __forceinline__ void done(const Unit&) const {}
};

typedef __bf16 bf16x2_native __attribute__((ext_vector_type(2)));
__device__ __forceinline__ unsigned cvt_pk_bf16(float lo, float hi) { const f32x2 v = {lo, hi}; const bf16x2_native r = __builtin_convertvector(v, bf16x2_native); return __builtin_bit_cast(unsigned, r); }
__device__ __forceinline__ f32x2 gelu_pk(f32x2 v) {
    const f32x2 av = __builtin_elementwise_abs(v), d = av * 0.2316418882f + 1.0f;
    f32x2 t; t.x = __builtin_amdgcn_rcpf(d.x); t.y = __builtin_amdgcn_rcpf(d.y);
    f32x2 q = t * 0.5307027145f + (-0.7265760135f); q = q * t + 0.7107068705f; q = q * t + (-0.142248368f); q = q * t + 0.127414796f; q = q * t;
    const f32x2 s = (v * v) * (-0.72134752044f);
    f32x2 e; e.x = __builtin_amdgcn_exp2f(s.x); e.y = __builtin_amdgcn_exp2f(s.y);
    const f32x2 m = v * (q * e), r = v - m;
    f32x2 o; o.x = v.x < 0.f ? m.x : r.x; o.y = v.y < 0.f ? m.y : r.y; return o;
}
__device__ __forceinline__ float sigmoid_f(float x) { return __builtin_amdgcn_rcpf(1.0f + __builtin_amdgcn_exp2f(-1.4426950408889634f * x)); }
__device__ __forceinline__ f32x4 sigmoid4(f32x4 v) { f32x4 o; o[0] = sigmoid_f(v[0]); o[1] = sigmoid_f(v[1]); o[2] = sigmoid_f(v[2]); o[3] = sigmoid_f(v[3]); return o; }
__device__ __forceinline__ f32x4 gelu4(f32x4 v) { const f32x2 a = gelu_pk((f32x2){v[0], v[1]}), b = gelu_pk((f32x2){v[2], v[3]}); return (f32x4){a.x, a.y, b.x, b.y}; }
__device__ __forceinline__ u32x4 pack8(f32x4 v0, f32x4 v1) { u32x4 w; w.x = cvt_pk_bf16(v0[0], v0[1]); w.y = cvt_pk_bf16(v0[2], v0[3]); w.z = cvt_pk_bf16(v1[0], v1[1]); w.w = cvt_pk_bf16(v1[2], v1[3]); return w; }

__device__ __forceinline__ unsigned pk_u8x4(f32x4 g) {
    const unsigned u0 = __float_as_uint(__builtin_fmaf(g[0], 255.0f, 8388608.0f)), u1 = __float_as_uint(__builtin_fmaf(g[1], 255.0f, 8388608.0f)),
                   u2 = __float_as_uint(__builtin_fmaf(g[2], 255.0f, 8388608.0f)), u3 = __float_as_uint(__builtin_fmaf(g[3], 255.0f, 8388608.0f));
    return (u0 & 0xffu) | ((u1 & 0xffu) << 8) | ((u2 & 0xffu) << 16) | (u3 << 24);
}
__device__ __forceinline__ f32x4 u8x4_f32(unsigned w) { return (f32x4){(float)(w & 0xffu), (float)((w >> 8) & 0xffu), (float)((w >> 16) & 0xffu), (float)(w >> 24)}; }
struct EpiF32 {
    static constexpr bool PERM = false, AFTER_DRAIN = false;
    float* C; int ldc;
    __device__ __forceinline__ void operator()(const f32x4 (&acc)[2][2][4][2], const Unit& u, int wr, int wc, int fr, int fq) const {
        const int row0 = u.pm * BM + wr * 64 + fr, col0 = u.pn * BM + wc * 32 + 4 * fq;
#pragma unroll
        for (int ai = 0; ai < 2; ++ai)
#pragma unroll
            for (int m = 0; m < 4; ++m) { float* rowp = C + (size_t)(row0 + ai * HALF + m * 16) * ldc + col0;
#pragma unroll
                for (int bj = 0; bj < 2; ++bj)
#pragma unroll
                    for (int n = 0; n < 2; ++n) *(f32x4*)(rowp + bj * HALF + n * 16) = acc[ai][bj][m][n]; }
    }
};
struct EpiBf16Plain {
    static constexpr bool PERM = true, AFTER_DRAIN = false;
    bf16_t* O; int ldc;
    __device__ __forceinline__ void operator()(const f32x4 (&acc)[2][2][4][2], const Unit& u, int wr, int wc, int fr, int fq) const {
        const int row0 = u.pm * BM + wr * 64 + fr, col0 = u.pn * BM + wc * 32 + 8 * fq;
#pragma unroll
        for (int ai = 0; ai < 2; ++ai)
#pragma unroll
            for (int m = 0; m < 4; ++m) { bf16_t* rowp = O + (size_t)(row0 + ai * HALF + m * 16) * ldc + col0;
#pragma unroll
                for (int bj = 0; bj < 2; ++bj) *(u32x4*)(rowp + bj * HALF) = pack8(acc[ai][bj][m][0], acc[ai][bj][m][1]); }
    }
};
struct EpiSwiGLU {
    static constexpr bool PERM = true, AFTER_DRAIN = false;
    bf16_t* O; int ldc;
    __device__ __forceinline__ void operator()(const f32x4 (&acc)[2][2][4][2], const Unit& u, int wr, int wc, int fr, int fq) const {
        const int row0 = u.pm * BM + wr * 64 + fr, col0 = u.pn * HALF + wc * 32 + 8 * fq;
#pragma unroll
        for (int ai = 0; ai < 2; ++ai)
#pragma unroll
            for (int m = 0; m < 4; ++m) { bf16_t* rowp = O + (size_t)(row0 + ai * HALF + m * 16) * ldc + col0;
                const f32x4 g0 = acc[ai][0][m][0], g1 = acc[ai][0][m][1];
                const f32x4 v0 = g0 * sigmoid4(g0) * acc[ai][1][m][0], v1 = g1 * sigmoid4(g1) * acc[ai][1][m][1];
                *(u32x4*)rowp = pack8(v0, v1); }
    }
};
struct EpiMix {
    static constexpr bool PERM = true, AFTER_DRAIN = false;
    bf16_t* PM; bf16_t* G; const float* gbias; int pn_off;
    __device__ __forceinline__ void operator()(const f32x4 (&acc)[2][2][4][2], const Unit& u, int wr, int wc, int fr, int fq) const {
        const int row0 = u.pm * BM + wr * 64 + fr, pn = u.pn + pn_off, lc = wc * 32 + 8 * fq;
        if (pn >= 16) {
            const int colt = (pn - 16) * BM + lc;
            f32x4 bv[2][2];
#pragma unroll
            for (int bj = 0; bj < 2; ++bj)
#pragma unroll
                for (int n = 0; n < 2; ++n) bv[bj][n] = *(const f32x4*)(gbias + colt + bj * HALF + 4 * n);
#pragma unroll
            for (int ai = 0; ai < 2; ++ai)
#pragma unroll
                for (int m = 0; m < 4; ++m) {
                    unsigned char* rowp = (unsigned char*)G + (size_t)(row0 + ai * HALF + m * 16) * 8192 + (pn - 16) * 256 + (wc * 4 + fq) * 16;
                    u32x4 o; o.x = pk_u8x4(sigmoid4(acc[ai][0][m][0] + bv[0][0])); o.y = pk_u8x4(sigmoid4(acc[ai][0][m][1] + bv[0][1]));
                    o.z = pk_u8x4(sigmoid4(acc[ai][1][m][0] + bv[1][0])); o.w = pk_u8x4(sigmoid4(acc[ai][1][m][1] + bv[1][1]));
                    *(u32x4*)rowp = o; }
        } else if (pn < 4 || pn >= 12) {
            const bool glu = pn < 4; const int colt = (glu ? pn * HALF : 2560 + (pn - 12) * HALF) + lc;
#pragma unroll
            for (int ai = 0; ai < 2; ++ai)
#pragma unroll
                for (int m = 0; m < 4; ++m) { bf16_t* rowp = PM + (size_t)(row0 + ai * HALF + m * 16) * 3072 + colt;
                    f32x4 b0 = acc[ai][1][m][0], b1 = acc[ai][1][m][1];
                    if (glu) { b0 = sigmoid4(b0); b1 = sigmoid4(b1); }
                    *(u32x4*)rowp = pack8(acc[ai][0][m][0] * b0, acc[ai][0][m][1] * b1); }
        } else {
            const bool gl = (pn >= 6 && pn < 10); const int colt = 512 + (pn - 4) * BM + lc;
#pragma unroll
            for (int ai = 0; ai < 2; ++ai)
#pragma unroll
                for (int m = 0; m < 4; ++m) { bf16_t* rowp = PM + (size_t)(row0 + ai * HALF + m * 16) * 3072 + colt;
#pragma unroll
                    for (int bj = 0; bj < 2; ++bj) { f32x4 v0 = acc[ai][bj][m][0], v1 = acc[ai][bj][m][1];
                        if (gl) { v0 = gelu4(v0); v1 = gelu4(v1); }
                        *(u32x4*)(rowp + bj * HALF) = pack8(v0, v1); } }
        }
    }
};

template <class Epi, class Sched, bool ALIGN_EPI = false, bool SP2 = false>
__device__ __forceinline__ void gemm_phase(PG8_LAS unsigned char* lds, const Gemm g, const Sched& S, const Epi& E) {
    int tid_ = threadIdx.x; asm volatile("" : "+v"(tid_));
    const int tid = tid_, wid = __builtin_amdgcn_readfirstlane(tid >> 6), lane = tid & 63, wr = wid >> 2, wc = wid & 3, fr = lane & 15, fq = lane >> 4;
    const int K = g.K, nt = K / BK;
    unsigned voffA[2], voffB[2];
#pragma unroll
    for (int i = 0; i < 2; ++i) { int R, C; stage_rc(tid * 16 + i * 8192, R, C); const int Rb = Epi::PERM ? ((R & ~31) + perm32(R & 31)) : R;
        voffA[i] = (unsigned)(R * K + C) * 2u; voffB[i] = (unsigned)(Rb * K + C) * 2u; }
    const size_t kstep = (size_t)(BK * 2);
    const size_t hstep = (size_t)HALF * K * 2;
    const size_t tstep = 2 * hstep;
    const unsigned ldsw = (unsigned)wid * 1024u;
    const int aoff = lds_byte(wr * 64 + fr, fq * 8), boff = lds_byte(wc * 32 + fr, fq * 8);
#define PG8_SA(b, h) (((b) * 2 + (h)) * HTB)
#define PG8_SB(b, h) ((4 + (b) * 2 + (h)) * HTB)
#define PG8_STAGE(bufoff, gbase, voff) do { _Pragma("unroll") for (int _i = 0; _i < 2; ++_i) \
        __builtin_amdgcn_global_load_lds((const unsigned*)((const char*)(gbase) + (voff)[_i]), (PG8_LAS unsigned*)(lds + (bufoff) + ldsw + _i * 8192), 16, 0, 0); } while (0)
#define PG8_LDA(dst, b, h) do { _Pragma("unroll") for (int m = 0; m < 4; ++m) _Pragma("unroll") for (int k = 0; k < 2; ++k) dst[m][k] = *(const PG8_LAS bf16x8*)(lds + PG8_SA(b, h) + aoff + m * 2048 + k * 1024); } while (0)
#define PG8_LDB(dst, b, h) do { _Pragma("unroll") for (int n = 0; n < 2; ++n) _Pragma("unroll") for (int k = 0; k < 2; ++k) dst[n][k] = *(const PG8_LAS bf16x8*)(lds + PG8_SB(b, h) + boff + n * 2048 + k * 1024); } while (0)
#define PG8_MMA(ai, bj, At, Bt) do { __builtin_amdgcn_s_setprio(1); _Pragma("unroll") for (int m = 0; m < 4; ++m) _Pragma("unroll") for (int n = 0; n < 2; ++n) _Pragma("unroll") for (int k = 0; k < 2; ++k) \
        acc[ai][bj][m][n] = __builtin_amdgcn_mfma_f32_16x16x32_bf16(Bt[n][k], At[m][k], acc[ai][bj][m][n], 0, 0, 0); __builtin_amdgcn_s_setprio(0); } while (0)
#define PG8_WAIT_V(n) asm volatile("s_waitcnt vmcnt(" #n ")" ::: "memory")
#define PG8_WAIT_L(n) asm volatile("s_waitcnt lgkmcnt(" #n ")" ::: "memory")
#define PG8_BAR __builtin_amdgcn_s_barrier()
#define PG8_SCHED __builtin_amdgcn_sched_barrier(0)
    Unit cur, nxt; int ui = 0;
    if (!S.next(0, cur)) return;
    f32x4 acc[2][2][4][2];
#pragma unroll
    for (int a = 0; a < 2; ++a)
#pragma unroll
        for (int b = 0; b < 2; ++b)
#pragma unroll
            for (int m = 0; m < 4; ++m)
#pragma unroll
                for (int n = 0; n < 2; ++n) acc[a][b][m][n] = (f32x4){0.f, 0.f, 0.f, 0.f};
    bf16x8 At[4][2], B0[2][2], B1[2][2];
    const char* cA = (const char*)g.A + (size_t)cur.pm * tstep; const char* cB = (const char*)g.Bt + (size_t)cur.pn * tstep;
    S.a_ready(cur);
    if constexpr (SP2) {
        PG8_STAGE(PG8_SB(0, 0), cB, voffB); PG8_STAGE(PG8_SB(0, 1), cB + hstep, voffB); PG8_STAGE(PG8_SA(0, 0), cA, voffA); PG8_STAGE(PG8_SA(0, 1), cA + hstep, voffA);
        if (wr == 1) PG8_BAR;
        PG8_WAIT_V(2); PG8_BAR;
        PG8_STAGE(PG8_SB(1, 0), cB + kstep, voffB); PG8_STAGE(PG8_SA(1, 0), cA + kstep, voffA); PG8_STAGE(PG8_SB(1, 1), cB + hstep + kstep, voffB);
        PG8_WAIT_V(6); PG8_BAR;
    } else {
        PG8_STAGE(PG8_SB(0, 0), cB, voffB); PG8_STAGE(PG8_SA(0, 0), cA, voffA); PG8_STAGE(PG8_SB(0, 1), cB + hstep, voffB); PG8_STAGE(PG8_SA(0, 1), cA + hstep, voffA);
        if (wr == 1) PG8_BAR;
        PG8_WAIT_V(4); PG8_BAR;
        PG8_STAGE(PG8_SB(1, 0), cB + kstep, voffB); PG8_STAGE(PG8_SA(1, 0), cA + kstep, voffA); PG8_STAGE(PG8_SB(1, 1), cB + hstep + kstep, voffB);
        PG8_WAIT_V(6); PG8_BAR;
    }
    for (;;) {
        const bool has_next = S.next(ui + 1, nxt);
        const char* nA = has_next ? (const char*)g.A + (size_t)nxt.pm * tstep : cA; const char* nB = has_next ? (const char*)g.Bt + (size_t)nxt.pn * tstep : cB;
        for (int t = 0; t < nt; t += 2) {
            const bool last = (t == nt - 2);
            const char* a1 = cA + (size_t)(t + 1) * kstep;
            const char* a2 = last ? nA : cA + (size_t)(t + 2) * kstep; const char* b2 = last ? nB : cB + (size_t)(t + 2) * kstep;
            const char* a3 = a2 + kstep; const char* b3 = b2 + kstep;
            if (last && has_next) S.a_ready(nxt);
            if constexpr (SP2) {
            PG8_LDB(B0, 0, 0); PG8_LDB(B1, 0, 1); PG8_SCHED; PG8_LDA(At, 0, 0); PG8_STAGE(PG8_SA(1, 1), a1 + hstep, voffA);
            PG8_WAIT_V(8); PG8_WAIT_L(0); PG8_BAR; PG8_MMA(0, 0, At, B0); PG8_MMA(0, 1, At, B1); PG8_BAR; PG8_SCHED;
            PG8_LDA(At, 0, 1); PG8_STAGE(PG8_SB(0, 0), b2, voffB); PG8_STAGE(PG8_SB(0, 1), b2 + hstep, voffB); PG8_STAGE(PG8_SA(0, 0), a2, voffA);
            PG8_WAIT_V(8); PG8_WAIT_L(0); PG8_BAR; PG8_MMA(1, 0, At, B0); PG8_MMA(1, 1, At, B1); PG8_BAR; PG8_SCHED;
            PG8_LDB(B0, 1, 0); PG8_LDB(B1, 1, 1); PG8_SCHED; PG8_LDA(At, 1, 0); PG8_STAGE(PG8_SA(0, 1), a2 + hstep, voffA);
            PG8_WAIT_V(8); PG8_WAIT_L(0); PG8_BAR; PG8_MMA(0, 0, At, B0); PG8_MMA(0, 1, At, B1); PG8_BAR; PG8_SCHED;
            PG8_LDA(At, 1, 1); PG8_STAGE(PG8_SB(1, 0), b3, voffB); PG8_STAGE(PG8_SB(1, 1), b3 + hstep, voffB); PG8_STAGE(PG8_SA(1, 0), a3, voffA);
            PG8_WAIT_V(8); PG8_WAIT_L(0); PG8_BAR; PG8_MMA(1, 0, At, B0); PG8_MMA(1, 1, At, B1); PG8_BAR; PG8_SCHED;
            } else {
            PG8_LDB(B0, 0, 0); PG8_SCHED; PG8_LDA(At, 0, 0); PG8_STAGE(PG8_SA(1, 1), a1 + hstep, voffA);
            PG8_WAIT_L(8); PG8_BAR; PG8_WAIT_L(0); PG8_MMA(0, 0, At, B0); PG8_BAR; PG8_SCHED;
            PG8_LDB(B1, 0, 1); PG8_STAGE(PG8_SB(0, 0), b2, voffB);
            PG8_BAR; PG8_WAIT_L(0); PG8_MMA(0, 1, At, B1); PG8_BAR;
            PG8_LDA(At, 0, 1); PG8_STAGE(PG8_SA(0, 0), a2, voffA);
            PG8_BAR; PG8_WAIT_L(0); PG8_MMA(1, 0, At, B0); PG8_BAR; PG8_SCHED;
            PG8_STAGE(PG8_SB(0, 1), b2 + hstep, voffB);
            PG8_WAIT_V(6); PG8_BAR; PG8_MMA(1, 1, At, B1); PG8_BAR;
            PG8_LDB(B0, 1, 0); PG8_SCHED; PG8_LDA(At, 1, 0); PG8_STAGE(PG8_SA(0, 1), a2 + hstep, voffA);
            PG8_WAIT_L(8); PG8_BAR; PG8_WAIT_L(0); PG8_MMA(0, 0, At, B0); PG8_BAR; PG8_SCHED;
            PG8_LDB(B1, 1, 1); PG8_STAGE(PG8_SB(1, 0), b3, voffB);
            PG8_BAR; PG8_WAIT_L(0); PG8_MMA(0, 1, At, B1); PG8_BAR;
            PG8_LDA(At, 1, 1); PG8_STAGE(PG8_SA(1, 0), a3, voffA);
            PG8_BAR; PG8_WAIT_L(0); PG8_MMA(1, 0, At, B0); PG8_BAR; PG8_SCHED;
            PG8_STAGE(PG8_SB(1, 1), b3 + hstep, voffB);
            PG8_WAIT_V(6); PG8_BAR; PG8_MMA(1, 1, At, B1); PG8_BAR;
            }
        }
        if constexpr (ALIGN_EPI) { if (wr == 0) PG8_BAR; }
        if constexpr (!Epi::AFTER_DRAIN) { E(acc, cur, wr, wc, fr, fq); S.done(cur); }
        if (!has_next) break;
#pragma unroll
        for (int a = 0; a < 2; ++a)
#pragma unroll
            for (int b = 0; b < 2; ++b)
#pragma unroll
                for (int m = 0; m < 4; ++m)
#pragma unroll
                    for (int n = 0; n < 2; ++n) acc[a][b][m][n] = (f32x4){0.f, 0.f, 0.f, 0.f};
        cur = nxt; cA = nA; cB = nB; ++ui;
        if constexpr (ALIGN_EPI) { if (wr == 1) PG8_BAR; }
    }
    PG8_WAIT_V(0);
    if constexpr (!ALIGN_EPI) { if (wr == 0) PG8_BAR; }
    PG8_BAR;
    if constexpr (Epi::AFTER_DRAIN) { E.fused(acc, cur, wr, wc, fr, fq, lds, wid, lane); S.done(cur); }
#undef PG8_SA
#undef PG8_SB
#undef PG8_STAGE
#undef PG8_LDA
#undef PG8_LDB
#undef PG8_MMA
#undef PG8_WAIT_V
#undef PG8_WAIT_L
#undef PG8_BAR
#undef PG8_SCHED
}

template <class Sched>
__device__ __forceinline__ void gated_merge3_phase(PG8_LAS unsigned char* lds, const bf16_t* A, const bf16_t* Bt, const bf16_t* Gt, bf16_t* O, const Sched& S) {
    int tid_ = threadIdx.x; asm volatile("" : "+v"(tid_));
    const int tid = tid_, wid = __builtin_amdgcn_readfirstlane(tid >> 6), lane = tid & 63, wr = wid >> 2, wc = wid & 3, fr = lane & 15, fq = lane >> 4;
    constexpr int K = 2048, nt = K / BK, STG = 3 * HTB;
    unsigned voffA[2], voffB[2];
#pragma unroll
    for (int i = 0; i < 2; ++i) { int R, C; stage_rc(tid * 16 + i * 8192, R, C); const int Rb = (R & ~31) + perm32(R & 31);
        voffA[i] = (unsigned)(R * K + C) * 2u; voffB[i] = (unsigned)(Rb * K + C) * 2u; }
    const size_t kstep = (size_t)(BK * 2);
    const size_t hstep = (size_t)HALF * K * 2;
    const size_t tstepA = hstep, tstepB = 2 * hstep;
    const unsigned ldsw = (unsigned)wid * 1024u;
    const int aoff = lds_byte(wr * 64 + fr, fq * 8) + 2 * HTB, boff = lds_byte(wc * 32 + fr, fq * 8);
#define M3_STAGE1(dst, gbase, voff) do { _Pragma("unroll") for (int _i = 0; _i < 2; ++_i) \
        __builtin_amdgcn_global_load_lds((const unsigned*)((const char*)(gbase) + (voff)[_i]), (PG8_LAS unsigned*)(lds + (dst) + ldsw + _i * 8192), 16, 0, 0); } while (0)
#define M3_STAGE(so, ap, bp) do { M3_STAGE1((so), (bp), voffB); M3_STAGE1((so) + HTB, (bp) + hstep, voffB); M3_STAGE1((so) + 2 * HTB, (ap), voffA); } while (0)
#define M3_WAIT_V(n) asm volatile("s_waitcnt vmcnt(" #n ")" ::: "memory")
#define M3_WAIT_L(n) asm volatile("s_waitcnt lgkmcnt(" #n ")" ::: "memory")
#define M3_BAR __builtin_amdgcn_s_barrier()
#define M3_SCHED __builtin_amdgcn_sched_barrier(0)
    Unit cur, nxt; int ui = 0;
    if (!S.next(0, cur)) return;
    f32x4 acc[2][4][2], mm[2][4][2];
#pragma unroll
    for (int a = 0; a < 2; ++a)
#pragma unroll
        for (int m = 0; m < 4; ++m)
#pragma unroll
            for (int n = 0; n < 2; ++n) { acc[a][m][n] = (f32x4){0.f, 0.f, 0.f, 0.f}; mm[a][m][n] = (f32x4){0.f, 0.f, 0.f, 0.f}; }
    bf16x8 At[4][2], B0[2][2], B1[2][2];
    u32x4 gp[4];
    const char* cA = (const char*)A + (size_t)cur.pm * tstepA; const char* cB = (const char*)Bt + (size_t)cur.pn * tstepB;
    M3_STAGE(0, cA, cB);
    if (wr == 1) M3_BAR;
    M3_WAIT_V(0); M3_BAR;
    M3_STAGE(STG, cA + kstep, cB + kstep);
    M3_BAR;
    int rs = 0;
    for (;;) {
        const bool has_next = S.next(ui + 1, nxt);
        const char* nA = has_next ? (const char*)A + (size_t)nxt.pm * tstepA : cA; const char* nB = has_next ? (const char*)Bt + (size_t)nxt.pn * tstepB : cB;
        const int grow0 = cur.pm * HALF + wr * 64 + fr, gcol0 = cur.pn * BM + wc * 32 + 8 * fq;
        for (int t = 0; t < nt; ++t) {
            const int t2 = t + 2; const bool wrap = t2 >= nt;
            const char* a2 = wrap ? nA + (size_t)(t2 - nt) * kstep : cA + (size_t)t2 * kstep;
            const char* b2 = wrap ? nB + (size_t)(t2 - nt) * kstep : cB + (size_t)t2 * kstep;
            const int ro = rs * STG; int ws2 = rs + 2; ws2 = ws2 >= 3 ? ws2 - 3 : ws2; const int so = ws2 * STG;
            const bool segend = ((t & 7) == 7);
            const bool gpre = ((t & 7) == 6);
            if (gpre) {
                const unsigned char* gb = (const unsigned char*)Gt + (size_t)grow0 * 8192 + ((t >> 3) * 8 + cur.pn) * 256 + (wc * 4 + fq) * 16;
#pragma unroll
                for (int m = 0; m < 4; ++m) gp[m] = *(const u32x4*)(gb + (size_t)(m * 16) * 8192);
            }
#pragma unroll
            for (int n = 0; n < 2; ++n)
#pragma unroll
                for (int k = 0; k < 2; ++k) { B0[n][k] = *(const PG8_LAS bf16x8*)(lds + ro + boff + n * 2048 + k * 1024); B1[n][k] = *(const PG8_LAS bf16x8*)(lds + ro + HTB + boff + n * 2048 + k * 1024); }
            M3_SCHED;
#pragma unroll
            for (int m = 0; m < 4; ++m)
#pragma unroll
                for (int k = 0; k < 2; ++k) At[m][k] = *(const PG8_LAS bf16x8*)(lds + ro + aoff + m * 2048 + k * 1024);
            M3_STAGE(so, a2, b2);
            if (gpre) M3_WAIT_V(10); else M3_WAIT_V(6);
            M3_WAIT_L(0); M3_BAR;
            __builtin_amdgcn_s_setprio(1);
#pragma unroll
            for (int m = 0; m < 4; ++m)
#pragma unroll
                for (int n = 0; n < 2; ++n)
#pragma unroll
                    for (int k = 0; k < 2; ++k) { acc[0][m][n] = __builtin_amdgcn_mfma_f32_16x16x32_bf16(B0[n][k], At[m][k], acc[0][m][n], 0, 0, 0);
                                                  acc[1][m][n] = __builtin_amdgcn_mfma_f32_16x16x32_bf16(B1[n][k], At[m][k], acc[1][m][n], 0, 0, 0); }
            __builtin_amdgcn_s_setprio(0);
            M3_BAR; M3_SCHED;
            rs = rs + 1; rs = rs >= 3 ? 0 : rs;
            if (segend) {
#pragma unroll
                for (int m = 0; m < 4; ++m) { const u32x4 g = gp[m];
                    mm[0][m][0] += u8x4_f32(g.x) * acc[0][m][0]; mm[0][m][1] += u8x4_f32(g.y) * acc[0][m][1];
                    mm[1][m][0] += u8x4_f32(g.z) * acc[1][m][0]; mm[1][m][1] += u8x4_f32(g.w) * acc[1][m][1];
#pragma unroll
                    for (int bj = 0; bj < 2; ++bj) { acc[bj][m][0] = (f32x4){0.f, 0.f, 0.f, 0.f}; acc[bj][m][1] = (f32x4){0.f, 0.f, 0.f, 0.f}; } }
            }
        }
#pragma unroll
        for (int bj = 0; bj < 2; ++bj)
#pragma unroll
            for (int m = 0; m < 4; ++m) { *(u32x4*)(O + (size_t)(grow0 + m * 16) * 2048 + gcol0 + bj * HALF) = pack8(mm[bj][m][0] * (1.0f / 255.0f), mm[bj][m][1] * (1.0f / 255.0f));
                mm[bj][m][0] = (f32x4){0.f, 0.f, 0.f, 0.f}; mm[bj][m][1] = (f32x4){0.f, 0.f, 0.f, 0.f}; }
        if (!has_next) break;
        cur = nxt; cA = nA; cB = nB; ++ui;
    }
    M3_WAIT_V(0);
    if (wr == 0) M3_BAR;
    M3_BAR;
#undef M3_STAGE1
#undef M3_STAGE
#undef M3_WAIT_V
#undef M3_WAIT_L
#undef M3_BAR
#undef M3_SCHED
}
}

#ifndef PG8_SP2
#define PG8_SP2 true
#endif
#ifndef PG8_ALIGN
#define PG8_ALIGN true
#endif
#ifndef P0_A_STEPS
#define P0_A_STEPS 20
#endif
#ifndef MK_PER_PHASE
#define MK_PER_PHASE 0
#endif

constexpr int S = 16384, D = 2048, FF = 5632, BW = 512, NL = 2;
constexpr int NMIXG = 12288;
constexpr int PMW = 3072;
constexpr int NADA = 9 * D;
constexpr float RMS_EPS = 1e-6f, LN_EPS = 1e-5f;
constexpr int NWAVES = 8, NTHREADS = NWAVES * 64;
constexpr int NPHASES = 2 + 11 * NL;

constexpr size_t MiB = 1u << 20;
constexpr size_t WS_CTL = 0, CTL_ZERO_BYTES = 1 * MiB;
constexpr size_t WS_ADAP = 1 * MiB;
constexpr size_t WS_POOLW = 2 * MiB;
constexpr size_t WS_SGUW = 2 * MiB + 256 * 1024;
constexpr size_t WS_WIN = 3 * MiB;
constexpr size_t WS_WOUT = WS_WIN + 176 * MiB;
constexpr size_t WS_WMIX = WS_WOUT + 88 * MiB;
constexpr size_t WS_WBR = WS_WMIX + 96 * MiB;
constexpr size_t WS_WO = WS_WBR + 16 * MiB;
constexpr size_t WS_NBUF = WS_WO + 16 * MiB;
constexpr size_t WS_ACT = WS_NBUF + 64 * MiB;
constexpr size_t WS_Z = WS_ACT + 176 * MiB;
constexpr size_t WS_PM = WS_Z + 128 * MiB;
constexpr size_t WS_G = WS_PM + 96 * MiB;
constexpr size_t WS_Y = WS_G + 256 * MiB;
constexpr size_t WS_MG = WS_Y + 64 * MiB;
constexpr size_t WS_XB = WS_MG + 64 * MiB;
constexpr size_t WS_END = WS_XB + 64 * MiB;
static_assert((size_t)NL * 2 * 2 * FF * D * 2 == 176 * MiB && (size_t)NL * 2 * D * FF * 2 == 88 * MiB && (size_t)NL * NMIXG * D * 2 == 96 * MiB, "weight map");
static_assert((size_t)S * FF * 2 == 176 * MiB && (size_t)S * PMW * 2 == 96 * MiB && (size_t)S * 8192 * 2 == 256 * MiB, "activation map");
constexpr int CW_TMO = 0, CW_CODE = 1, CW_ADA = 128;
constexpr int CW_BAR = 4096;

constexpr int RING_OFF = 0, RING_BYTES = 147456;
constexpr int LDSCTL_OFF = RING_BYTES, MISC_OFF = LDSCTL_OFF + 320;
constexpr int LDS_BYTES = 163840;
static_assert(MISC_OFF + 128 <= LDS_BYTES, "LDS map");

#define GAS __attribute__((address_space(1)))
#define LAS __attribute__((address_space(3)))
typedef unsigned short bf16;
typedef unsigned v4u __attribute__((ext_vector_type(4)));
typedef unsigned v2u __attribute__((ext_vector_type(2)));
typedef float f32x4 __attribute__((ext_vector_type(4)));
typedef float f32x2 __attribute__((ext_vector_type(2)));
typedef short bf16x8 __attribute__((ext_vector_type(8)));
typedef GAS unsigned gu32;
#define RLX_AGENT __ATOMIC_RELAXED, __HIP_MEMORY_SCOPE_AGENT
#define LDS_WAIT() asm volatile("s_waitcnt lgkmcnt(0)" ::: "memory")
#define VM_WAIT() asm volatile("s_waitcnt vmcnt(0)" ::: "memory")
__device__ __forceinline__ unsigned f2bf(float f) { unsigned u = __builtin_bit_cast(unsigned, f); return (u + 0x7fffu + ((u >> 16) & 1u)) >> 16; }
__device__ __forceinline__ unsigned pk2(float lo, float hi) { return pg8::cvt_pk_bf16(lo, hi); }
__device__ __forceinline__ float bf_lo(unsigned w) { return __uint_as_float(w << 16); }
__device__ __forceinline__ float bf_hi(unsigned w) { return __uint_as_float(w & 0xffff0000u); }
__device__ __forceinline__ float wave_sum(float v) {
#pragma unroll
    for (int o = 1; o < 64; o <<= 1) v += __shfl_xor(v, o);
    return v;
}
template <int N> __device__ __forceinline__ void wave_sum_n(float (&v)[N]) {
#pragma unroll
    for (int o = 1; o < 64; o <<= 1) {
        float t[N];
#pragma unroll
        for (int i = 0; i < N; ++i) t[i] = __shfl_xor(v[i], o);
#pragma unroll
        for (int i = 0; i < N; ++i) v[i] += t[i];
    }
}
#define XB_TMO      128
#define XB_XCNT(j)  (256  + 64 * (j))
#define XB_XSUB(j)  (1280 + 64 * (j))
#define XB_XGEN(j)  (2304 + 64 * (j))
#define XB_TOP      3328
#define XB_TOPGEN   3392
#define XCD_BAR_WORDS 3456
#define XB_SPIN_CAP (1u << 18)

__device__ __forceinline__ unsigned xb_ld(unsigned* p)              { return __hip_atomic_load(p, __ATOMIC_RELAXED, __HIP_MEMORY_SCOPE_AGENT); }
__device__ __forceinline__ unsigned xb_add(unsigned* p, unsigned v) { return __hip_atomic_fetch_add(p, v, __ATOMIC_RELAXED, __HIP_MEMORY_SCOPE_AGENT); }
__device__ __forceinline__ unsigned xb_xcc_id() { return (unsigned)__builtin_amdgcn_s_getreg((3 << 11) | 20) & 0xFu; }
#define XB_SPIN(cond, bar) do { unsigned _sp = 0; while (cond) { __builtin_amdgcn_s_sleep(1); \
    if ((++_sp & 255u) == 0u) { if (xb_ld(&(bar)[XB_TMO])) break; if (_sp > XB_SPIN_CAP) { atomicAdd(&(bar)[XB_TMO], 1u); break; } } } } while (0)

struct XcdBarrier {
    unsigned* bar; unsigned x;
    volatile LAS unsigned* st;
};

__device__ __forceinline__ XcdBarrier xcd_barrier_post(unsigned* bar, volatile LAS unsigned* st) {
    XcdBarrier b; b.bar = bar; b.x = xb_xcc_id(); b.st = st;
    if (threadIdx.x == 0) (void)xb_add(&bar[XB_XCNT(b.x)], 1u);
    return b;
}
__device__ __forceinline__ void xcd_barrier_complete(unsigned* bar, unsigned x, unsigned& nloc, unsigned& nx) {
    const unsigned G = gridDim.x * gridDim.y * gridDim.z;
    unsigned sum, cnt, mine, sp = 0u;
    for (;;) {
        sum = 0u; cnt = 0u; mine = 0u;
#pragma unroll
        for (unsigned j = 0; j < 16; ++j) { const unsigned c = xb_ld(&bar[XB_XCNT(j)]); sum += c; cnt += (c > 0u) ? 1u : 0u; mine = (j == x) ? c : mine; }
        if (sum == G) break;
        __builtin_amdgcn_s_sleep(1);
        if ((++sp & 255u) == 0u) { if (xb_ld(&bar[XB_TMO])) break; if (sp > XB_SPIN_CAP) { atomicAdd(&bar[XB_TMO], 1u); break; } }
    }
    nloc = mine > 0u ? mine : 1u; nx = cnt > 0u ? cnt : 1u;
}

__device__ __forceinline__ void xcd_barrier(const XcdBarrier& b) {
    asm volatile("s_waitcnt vmcnt(0)" ::: "memory");
    __syncthreads();
    if (threadIdx.x == 0) {
        unsigned* bar = b.bar;
        __builtin_amdgcn_s_waitcnt(0);
        unsigned nloc = b.st[0], nx = b.st[1];
        if (nloc == 0u) { xcd_barrier_complete(bar, b.x, nloc, nx); b.st[0] = nloc; b.st[1] = nx; }
        const unsigned old = xb_add(&bar[XB_XSUB(b.x)], 1u);
        const unsigned gen = old / nloc;
        if (old + 1u == (gen + 1u) * nloc) {
            __builtin_amdgcn_fence(__ATOMIC_RELEASE, "agent");
            asm volatile("s_waitcnt vmcnt(0)" ::: "memory");
            const unsigned og = xb_add(&bar[XB_TOP], 1u);
            const unsigned tg = og / nx;
            if (og + 1u == (tg + 1u) * nx) xb_add(&bar[XB_TOPGEN], 1u);
            else XB_SPIN(xb_ld(&bar[XB_TOPGEN]) == tg, bar);
            __builtin_amdgcn_fence(__ATOMIC_ACQUIRE, "agent");
            xb_add(&bar[XB_XGEN(b.x)], 1u);
            asm volatile("s_waitcnt vmcnt(0)" ::: "memory");
        } else {
            XB_SPIN(xb_ld(&bar[XB_XGEN(b.x)]) == gen, bar);
            __builtin_amdgcn_fence(__ATOMIC_ACQUIRE, "agent");
            asm volatile("s_waitcnt vmcnt(0)" ::: "memory");
        }
    }
    __syncthreads();
}


struct TrJob { const float* src; bf16* dst; int ldw, ldk; };
__device__ __forceinline__ void tr_load(const TrJob& j, f32x4 (&v)[8][2], int lane) {
    const int rsub = lane >> 4, cg = lane & 15;
#pragma unroll
    for (int jp = 0; jp < 8; ++jp)
#pragma unroll
        for (int par = 0; par < 2; ++par) v[jp][par] = *(const f32x4*)(j.src + (size_t)(8 * jp + 2 * rsub + par) * j.ldw + 4 * cg);
}
__device__ __forceinline__ void tr_finish(const TrJob& j, const f32x4 (&v)[8][2], LAS unsigned* scr, int lane) {
    const int rsub = lane >> 4, cg = lane & 15;
#pragma unroll
    for (int jp = 0; jp < 8; ++jp)
#pragma unroll
        for (int e = 0; e < 4; ++e) scr[(4 * jp + rsub) * 65 + 4 * cg + e] = pk2(v[jp][0][e], v[jp][1][e]);
    LDS_WAIT(); asm volatile("" ::: "memory");
    const int nl = lane >> 3, c = lane & 7;
#pragma unroll
    for (int jj = 0; jj < 8; ++jj) { const int n = nl + 8 * jj; v4u o;
        o.x = scr[(4 * c + 0) * 65 + n]; o.y = scr[(4 * c + 1) * 65 + n]; o.z = scr[(4 * c + 2) * 65 + n]; o.w = scr[(4 * c + 3) * 65 + n];
        *(v4u*)(j.dst + (size_t)n * j.ldk + 8 * c) = o; }
    LDS_WAIT(); asm volatile("" ::: "memory");
}
constexpr int CONV_ITEMS_PER_LAYER = 25104, N_ADA_ITEMS = 2304, N_SGU_ITEMS = 256;
constexpr int N_P0_ITEMS = N_ADA_ITEMS + NL * CONV_ITEMS_PER_LAYER + N_SGU_ITEMS;

struct Args { const float* in[24]; float* out; unsigned char* ws; int ph_lo, ph_hi; };


typedef const __attribute__((address_space(4))) Args* KArgs;
__device__ __forceinline__ KArgs kargs() { KArgs p = (KArgs)__builtin_amdgcn_kernarg_segment_ptr(); asm volatile("" : "+s"(p)); return p; }
__device__ __forceinline__ TrJob p0_conv_job(KArgs a, int it) {
    unsigned char* ws = a->ws;
    const int l = it / CONV_ITEMS_PER_LAYER; int r = it % CONV_ITEMS_PER_LAYER;
    const float* src; int ldw; bf16* dst; int ldk;
    if (r < 11264) { const int i = r / 5632; r %= 5632; const int kb = r / 176, nb = r % 176, n0 = 64 * nb, pn = n0 >> 8, s = (n0 >> 7) & 1, r0 = n0 & 127;
        src = a->in[6] + ((size_t)(l * 2 + i) * D + 64 * kb) * (2 * FF) + s * FF + 128 * pn + r0; ldw = 2 * FF;
        dst = (bf16*)(ws + WS_WIN) + ((size_t)(l * 2 + i) * 2 * FF + n0) * D + 64 * kb; ldk = D; }
    else if ((r -= 11264) < 5632) { const int i = r / 2816; r %= 2816; const int kb = r / 32, nb = r % 32, n0 = 64 * nb;
        src = a->in[7] + ((size_t)(l * 2 + i) * FF + 64 * kb) * D + n0; ldw = D;
        dst = (bf16*)(ws + WS_WOUT) + ((size_t)(l * 2 + i) * D + n0) * FF + 64 * kb; ldk = FF; }
    else if ((r -= 5632) < 2048) { const int kb = r / 64, nb = r % 64, n0 = 64 * nb, t = n0 >> 8, rr = n0 & 255; int sc;
        if (t < 4) sc = (rr >> 7) * 512 + 128 * t + (rr & 127); else if (t < 12) sc = 1024 + (t - 4) * 256 + rr; else sc = 3072 + (rr >> 7) * 512 + 128 * (t - 12) + (rr & 127);
        src = a->in[8] + ((size_t)l * D + 64 * kb) * 4096 + sc; ldw = 4096;
        dst = (bf16*)(ws + WS_WMIX) + ((size_t)l * NMIXG + n0) * D + 64 * kb; ldk = D; }
    else if ((r -= 2048) < 4096) { const int b = r / 1024; r %= 1024; const int kb = r / 32, nb = r % 32, n0 = 64 * nb;
        src = a->in[9] + ((size_t)(l * 4 + b) * D + 64 * kb) * D + n0; ldw = D;
        dst = (bf16*)(ws + WS_WMIX) + ((size_t)l * NMIXG + 4096 + b * 2048 + n0) * D + 64 * kb; ldk = D; }
    else if ((r -= 4096) < 1024) { const int b = r / 256; r %= 256; const int kb = r / 32, nb = r % 32, n0 = 64 * nb;
        src = a->in[22] + ((size_t)(l * 4 + b) * BW + 64 * kb) * D + n0; ldw = D;
        dst = (bf16*)(ws + WS_WBR) + ((size_t)l * D + n0) * 2048 + b * 512 + 64 * kb; ldk = 2048; }
    else if ((r -= 1024) < 1024) { const int kb = r / 32, nb = r % 32, n0 = 64 * nb;
        src = a->in[23] + ((size_t)l * D + 64 * kb) * D + n0; ldw = D;
        dst = (bf16*)(ws + WS_WO) + ((size_t)l * D + n0) * D + 64 * kb; ldk = D; }
    else { r -= 1024; const int g = r / 4; r %= 4; const int kb = r / 2, nb = r % 2, n0 = 64 * nb;
        src = a->in[15] + ((size_t)(l * 4 + g) * 128 + 64 * kb) * 128 + n0; ldw = 128;
        dst = (bf16*)(ws + WS_POOLW) + ((size_t)(l * 4 + g) * 128 + n0) * 128 + 64 * kb; ldk = 128; }
    TrJob j; j.src = src; j.dst = dst; j.ldw = ldw; j.ldk = ldk; return j;
}
__device__ __forceinline__ void p0_ada_item(KArgs a, int it, int lane) {
    const int ks = it / 576, cb = it % 576, col = cb * 64 + lane, l = col / NADA, j = col % NADA;
    const float* w = a->in[2] + ((size_t)l * D + ks * 512) * NADA + j; const float* cvec = a->in[1] + ks * 512;
    float acc0 = 0.f, acc1 = 0.f;
    for (int k0 = 0; k0 < 512; k0 += 64) {
        float cv = cvec[k0 + lane]; cv = cv / (1.0f + __expf(-cv));
        float wv[64];
#pragma unroll
        for (int i = 0; i < 64; ++i) wv[i] = w[(size_t)(k0 + i) * NADA];
#pragma unroll
        for (int i = 0; i < 64; i += 2) {
            acc0 += __uint_as_float((unsigned)__builtin_amdgcn_readlane((int)__float_as_uint(cv), i)) * wv[i];
            acc1 += __uint_as_float((unsigned)__builtin_amdgcn_readlane((int)__float_as_uint(cv), i + 1)) * wv[i + 1]; }
    }
    __hip_atomic_store((gu32*)(a->ws + WS_ADAP) + (size_t)ks * (NL * NADA) + col, __float_as_uint(acc0 + acc1), RLX_AGENT);
}
__device__ __forceinline__ void p0_sgu_item(KArgs a, int it, int lane) {
    const int e = it * 512 + lane * 8, t = (e >> 7) & 127, j0 = e & 127;
    const f32x4 v0 = *(const f32x4*)(a->in[19] + e), v1 = *(const f32x4*)(a->in[19] + e + 4);
    float x[8] = {v0[0], v0[1], v0[2], v0[3], v1[0], v1[1], v1[2], v1[3]};
#pragma unroll
    for (int i = 0; i < 8; ++i) x[i] = (j0 + i <= t) ? x[i] : 0.f;
    v4u o; o.x = pk2(x[0], x[1]); o.y = pk2(x[2], x[3]); o.z = pk2(x[4], x[5]); o.w = pk2(x[6], x[7]);
    *(v4u*)((bf16*)(a->ws + WS_SGUW) + e) = o;
}
__device__ __forceinline__ float ada_val(const float* adap, const float* ada_b, int idx) {
    return ada_b[idx] + ((adap[idx] + adap[NL * NADA + idx]) + (adap[2 * NL * NADA + idx] + adap[3 * NL * NADA + idx]));
}

template <bool HAS_RES, bool HAS_NEXT, bool XIN_F32, bool XOUT_F32>
__device__ __forceinline__ void resnorm_phase(LAS unsigned char* lds, const void* xin_, void* xout_, const bf16* z, bf16* nbuf, const float* adap, const float* ada_b,
                                              const float* post_g, int off_gate, float coef, const float* pre_g_next, int off_next, int gw, int NGW, int tid, int lane) {
    asm volatile("" : "+v"(tid)); lane = tid & 63;
    LAS float* vA = (LAS float*)lds; LAS float* vB = vA + D; LAS float* vC = vB + D;
    {
        constexpr int NJ = D / NTHREADS;
        float pg_[NJ][5], ps_[NJ][5], ph_[NJ][5], gq_[NJ], gn_[NJ];
#pragma unroll
        for (int j = 0; j < NJ; ++j) { const int d = tid + j * NTHREADS;
            if (HAS_RES) {
#pragma unroll
                for (int p = 0; p < 4; ++p) pg_[j][p] = adap[p * (NL * NADA) + off_gate + d];
                pg_[j][4] = ada_b[off_gate + d]; gq_[j] = post_g[d]; }
            if (HAS_NEXT) {
#pragma unroll
                for (int p = 0; p < 4; ++p) { ps_[j][p] = adap[p * (NL * NADA) + off_next + D + d]; ph_[j][p] = adap[p * (NL * NADA) + off_next + d]; }
                ps_[j][4] = ada_b[off_next + D + d]; ph_[j][4] = ada_b[off_next + d]; gn_[j] = pre_g_next[d]; } }
        asm volatile("" ::: "memory");
#pragma unroll
        for (int j = 0; j < NJ; ++j) { const int d = tid + j * NTHREADS;
            if (HAS_RES) vA[d] = coef * (pg_[j][4] + ((pg_[j][0] + pg_[j][1]) + (pg_[j][2] + pg_[j][3]))) * gq_[j];
            if (HAS_NEXT) { vB[d] = gn_[j] * (1.0f + (ps_[j][4] + ((ps_[j][0] + ps_[j][1]) + (ps_[j][2] + ps_[j][3])))); vC[d] = ph_[j][4] + ((ph_[j][0] + ph_[j][1]) + (ph_[j][2] + ph_[j][3])); } }
    }
    __syncthreads();
    const float* xinf = (const float*)xin_; const bf16* xinb = (const bf16*)xin_; float* xoutf = (float*)xout_; bf16* xoutb = (bf16*)xout_;
    for (int row0 = gw; row0 < S; row0 += 2 * NGW) {
        f32x4 xf[2][8]; v2u xc[2][8], zc[2][8];
#pragma unroll
        for (int r = 0; r < 2; ++r) { int row = row0 + r * NGW; asm volatile("" : "+s"(row));
            if (XIN_F32) { const f32x4* xr = (const f32x4*)(xinf + (size_t)row * D) + lane;
#pragma unroll
                for (int j = 0; j < 8; ++j) xf[r][j] = xr[64 * j];
            } else { const v2u* xr = (const v2u*)(xinb + (size_t)row * D) + lane;
#pragma unroll
                for (int j = 0; j < 8; ++j) xc[r][j] = xr[64 * j]; }
            if (HAS_RES) { const v2u* zr = (const v2u*)(z + (size_t)row * D) + lane;
#pragma unroll
                for (int j = 0; j < 8; ++j) zc[r][j] = zr[64 * j]; }
        }
#pragma unroll
        for (int r = 0; r < 2; ++r) { int row = row0 + r * NGW; asm volatile("" : "+s"(row));
            f32x4 xv[8];
#pragma unroll
            for (int j = 0; j < 8; ++j) xv[j] = XIN_F32 ? xf[r][j] : (f32x4){bf_lo(xc[r][j].x), bf_hi(xc[r][j].x), bf_lo(xc[r][j].y), bf_hi(xc[r][j].y)};
            if (HAS_RES) {
                f32x4 zv[8]; float ss = 0.f;
#pragma unroll
                for (int j = 0; j < 8; ++j) { const v2u zz = zc[r][j]; zv[j] = (f32x4){bf_lo(zz.x), bf_hi(zz.x), bf_lo(zz.y), bf_hi(zz.y)}; ss += (zv[j][0] * zv[j][0] + zv[j][1] * zv[j][1]) + (zv[j][2] * zv[j][2] + zv[j][3] * zv[j][3]); }
                const float rz = rsqrtf(wave_sum(ss) * (1.0f / D) + RMS_EPS);
#pragma unroll
                for (int j = 0; j < 8; ++j) { const f32x4 av = *(const LAS f32x4*)(vA + 4 * lane + 256 * j); xv[j] = xv[j] + av * zv[j] * rz; }
                if (XOUT_F32) { f32x4* xo = (f32x4*)(xoutf + (size_t)row * D) + lane;
#pragma unroll
                    for (int j = 0; j < 8; ++j) xo[64 * j] = xv[j];
                } else { v2u* xo = (v2u*)(xoutb + (size_t)row * D) + lane;
#pragma unroll
                    for (int j = 0; j < 8; ++j) { v2u o; o.x = pk2(xv[j][0], xv[j][1]); o.y = pk2(xv[j][2], xv[j][3]); xo[64 * j] = o;
                        xv[j] = (f32x4){bf_lo(o.x), bf_hi(o.x), bf_lo(o.y), bf_hi(o.y)}; }
                }
            }
            if (HAS_NEXT) {
                float ss = 0.f;
#pragma unroll
                for (int j = 0; j < 8; ++j) ss += (xv[j][0] * xv[j][0] + xv[j][1] * xv[j][1]) + (xv[j][2] * xv[j][2] + xv[j][3] * xv[j][3]);
                const float rx = rsqrtf(wave_sum(ss) * (1.0f / D) + RMS_EPS);
                v2u* no = (v2u*)(nbuf + (size_t)row * D) + lane;
#pragma unroll
                for (int j = 0; j < 8; ++j) { const f32x4 bv = *(const LAS f32x4*)(vB + 4 * lane + 256 * j), cv = *(const LAS f32x4*)(vC + 4 * lane + 256 * j);
                    const f32x4 n = xv[j] * rx * bv + cv; v2u o; o.x = pk2(n[0], n[1]); o.y = pk2(n[2], n[3]); no[64 * j] = o; }
            }
        }
    }
    __syncthreads();
}

__device__ __forceinline__ void unpack8(const v4u r, float (&x)[8]) { x[0] = bf_lo(r.x); x[1] = bf_hi(r.x); x[2] = bf_lo(r.y); x[3] = bf_hi(r.y); x[4] = bf_lo(r.z); x[5] = bf_hi(r.z); x[6] = bf_lo(r.w); x[7] = bf_hi(r.w); }
template <int ROWS> __device__ __forceinline__ void load_window(LAS unsigned char* lds, const bf16* PMb, int colbyte, int t_first, int tid) {
    constexpr int N = ROWS * 64, NIT = (N + NTHREADS - 1) / NTHREADS;
    const __amdgpu_buffer_rsrc_t rs = __builtin_amdgcn_make_buffer_rsrc((void*)PMb, 0, (int)((size_t)S * PMW * 2), 0x00020000);
    v4u v[NIT];
#pragma unroll
    for (int q = 0; q < NIT; ++q) { const int i = tid + q * NTHREADS, r = i >> 6, ch = i & 63, t = t_first + r;
        const unsigned off = (i < N && t >= 0) ? (unsigned)t * (unsigned)(PMW * 2) + (unsigned)(colbyte + ch * 16) : 0xFFFFFFF0u;
        v[q] = __builtin_bit_cast(v4u, __builtin_amdgcn_raw_buffer_load_b128(rs, off, 0, 0)); }
#pragma unroll
    for (int q = 0; q < NIT; ++q) { const int i = tid + q * NTHREADS, r = i >> 6, ch = i & 63; if (i < N) *(LAS v4u*)(lds + r * 1024 + ch * 16) = v[q]; }
}
__device__ __forceinline__ void mix_conv_unit(LAS unsigned char* lds, const bf16* PM, bf16* Y, const float* cw, const float* cbias, const float* lng, const float* lnb, int t0, int tid, int lane, int wave) {
    asm volatile("" : "+v"(tid)); lane = tid & 63;
    LAS unsigned* win = (LAS unsigned*)lds;
    LAS float* cout = (LAS float*)(lds + 63488);
    load_window<62>(lds, PM, 0, t0 - 30, tid);
    const int cp = tid & 255, th = tid >> 8;
    f32x2 wk[31];
#pragma unroll
    for (int k = 0; k < 31; ++k) wk[k] = *(const f32x2*)(cw + k * BW + 2 * cp);
    const f32x2 cb = *(const f32x2*)(cbias + 2 * cp);
    __syncthreads();
    for (int blk = 0; blk < 2; ++blk) {
        const int tb = th * 16 + blk * 8;
        f32x2 acc[8];
#pragma unroll
        for (int o = 0; o < 8; ++o) acc[o] = cb;
#pragma unroll
        for (int i = 0; i < 38; ++i) {
            const unsigned wv = win[(tb + i) * 256 + cp]; const f32x2 v = (f32x2){bf_lo(wv), bf_hi(wv)};
#pragma unroll
            for (int o = 0; o < 8; ++o) { const int k = i - o; if (k >= 0 && k <= 30) acc[o] += wk[k] * v; }
            if ((i & 3) == 3) asm volatile("" ::: "memory");
        }
#pragma unroll
        for (int o = 0; o < 8; ++o) *(LAS f32x2*)(cout + (tb + o) * BW + 2 * cp) = acc[o];
    }
    __syncthreads();
    const f32x4 g0 = *(const f32x4*)(lng + lane * 8), g1 = *(const f32x4*)(lng + lane * 8 + 4), b0 = *(const f32x4*)(lnb + lane * 8), b1 = *(const f32x4*)(lnb + lane * 8 + 4);
    { f32x4 a0[4], a1[4]; float sm[4], sq[4];
#pragma unroll
      for (int q = 0; q < 4; ++q) { const int tok = wave * 4 + q; a0[q] = *(const LAS f32x4*)(cout + tok * BW + lane * 8); a1[q] = *(const LAS f32x4*)(cout + tok * BW + lane * 8 + 4);
          sm[q] = (a0[q][0] + a0[q][1]) + (a0[q][2] + a0[q][3]) + (a1[q][0] + a1[q][1]) + (a1[q][2] + a1[q][3]); }
      wave_sum_n<4>(sm);
#pragma unroll
      for (int q = 0; q < 4; ++q) { const float mean = sm[q] * (1.0f / BW); a0[q] = a0[q] - mean; a1[q] = a1[q] - mean;
          sq[q] = (a0[q][0] * a0[q][0] + a0[q][1] * a0[q][1]) + (a0[q][2] * a0[q][2] + a0[q][3] * a0[q][3]) + (a1[q][0] * a1[q][0] + a1[q][1] * a1[q][1]) + (a1[q][2] * a1[q][2] + a1[q][3] * a1[q][3]); }
      wave_sum_n<4>(sq);
#pragma unroll
      for (int q = 0; q < 4; ++q) { const int tok = wave * 4 + q; const float rstd = rsqrtf(sq[q] * (1.0f / BW) + LN_EPS);
          f32x4 y0 = a0[q] * rstd * g0 + b0, y1 = a1[q] * rstd * g1 + b1;
          y0 = y0 * pg8::sigmoid4(y0); y1 = y1 * pg8::sigmoid4(y1);
          *(v4u*)(Y + (size_t)(t0 + tok) * D + lane * 8) = pg8::pack8(y0, y1); } }
    __syncthreads();
}
template <int WN> __device__ __forceinline__ void pool_window(const f32x2 (&xw)[31], f32x2 (&sres)[16]) {
    f32x2 s = (f32x2){0.f, 0.f};
#pragma unroll
    for (int j = 0; j < WN; ++j) s += xw[15 - j];
    sres[0] = s;
#pragma unroll
    for (int o = 1; o < 16; ++o) { s += xw[15 + o] - xw[15 + o - WN]; sres[o] = s; }
}
__device__ __forceinline__ void mix_pool_unit(LAS unsigned char* lds, const bf16* PM, bf16* Y, const bf16* pw, const float* pscale, int t0, int tid, int lane, int wave) {
    asm volatile("" : "+v"(tid)); lane = tid & 63;
    LAS unsigned* pin = (LAS unsigned*)lds;
    LAS unsigned char* pimg = lds + 48128;
    load_window<47>(lds, PM, 1024, t0 - 15, tid);
    __syncthreads();
    { const int cp = tid & 255, th = tid >> 8, grp = cp >> 6;
      f32x2 xw[31];
#pragma unroll
      for (int k = 0; k < 31; ++k) { const unsigned w = pin[(th * 16 + k) * 256 + cp]; xw[k] = (f32x2){bf_lo(w), bf_hi(w)}; }
      f32x2 sres[16];
      if (grp == 0) pool_window<2>(xw, sres); else if (grp == 1) pool_window<4>(xw, sres); else if (grp == 2) pool_window<8>(xw, sres); else pool_window<16>(xw, sres);
      const int wn = 2 << grp;
#pragma unroll
      for (int o = 0; o < 16; ++o) { const int tok = th * 16 + o, tg = t0 + tok; const float cnt = (float)((tg + 1) < wn ? (tg + 1) : wn);
          *(LAS unsigned*)(pimg + tok * 1040 + cp * 4) = pk2(sres[o].x / cnt - xw[15 + o].x, sres[o].y / cnt - xw[15 + o].y); } }
    __syncthreads();
    { const int g2 = wave >> 1, dh = wave & 1, fr = lane & 15, fq = lane >> 4;
      bf16x8 Pf[2][4];
#pragma unroll
      for (int rb = 0; rb < 2; ++rb)
#pragma unroll
          for (int ks = 0; ks < 4; ++ks) Pf[rb][ks] = *(const LAS bf16x8*)(pimg + (rb * 16 + fr) * 1040 + (g2 * 128 + ks * 32 + 8 * fq) * 2);
#pragma unroll
      for (int cb = 0; cb < 4; ++cb) { const int d0 = dh * 64 + cb * 16;
          bf16x8 Wf[4];
#pragma unroll
          for (int ks = 0; ks < 4; ++ks) Wf[ks] = *(const bf16x8*)(pw + (size_t)(g2 * 128 + d0 + fr) * 128 + ks * 32 + 8 * fq);
          f32x4 a0 = (f32x4){0.f, 0.f, 0.f, 0.f}, a1 = (f32x4){0.f, 0.f, 0.f, 0.f};
#pragma unroll
          for (int ks = 0; ks < 4; ++ks) { a0 = __builtin_amdgcn_mfma_f32_16x16x32_bf16(Wf[ks], Pf[0][ks], a0, 0, 0, 0); a1 = __builtin_amdgcn_mfma_f32_16x16x32_bf16(Wf[ks], Pf[1][ks], a1, 0, 0, 0); }
          const f32x4 sc = *(const f32x4*)(pscale + g2 * 128 + d0 + 4 * fq);
          a0 = a0 * sc; a1 = a1 * sc;
          v2u o0, o1; o0.x = pk2(a0[0], a0[1]); o0.y = pk2(a0[2], a0[3]); o1.x = pk2(a1[0], a1[1]); o1.y = pk2(a1[2], a1[3]);
          *(v2u*)(Y + (size_t)(t0 + fr) * D + 512 + g2 * 128 + d0 + 4 * fq) = o0;
          *(v2u*)(Y + (size_t)(t0 + 16 + fr) * D + 512 + g2 * 128 + d0 + 4 * fq) = o1; } }
    __syncthreads();
}
__device__ __forceinline__ void mix_sgu_unit(LAS unsigned char* lds, const bf16* PM, bf16* Y, const bf16* sw, const float* lng, const float* lnb, const float* bs, int ci, int g, int tid, int lane, int wave) {
    asm volatile("" : "+v"(tid)); lane = tid & 63;
    LAS unsigned char* vimg = lds + 1024;
    const int t0 = ci * 128, c0 = 16 * wave, fr = lane & 15, fq = lane >> 4;
    v4u raw[16];
#pragma unroll
    for (int q = 0; q < 16; ++q) raw[q] = *(const v4u*)(PM + (size_t)(t0 + wave * 16 + q) * PMW + 1536 + lane * 8);
    v2u ur[8]; float bsv[8];
#pragma unroll
    for (int tb = 0; tb < 8; ++tb) { const int t = tb * 16 + fr; bsv[tb] = bs[g * 128 + t]; ur[tb] = *(const v2u*)(PM + (size_t)(t0 + t) * PMW + 1024 + g * 128 + c0 + 4 * fq); }
    const int cl = (lane & 15) * 8;
    const f32x4 g0 = *(const f32x4*)(lng + g * 128 + cl), g1 = *(const f32x4*)(lng + g * 128 + cl + 4), b0 = *(const f32x4*)(lnb + g * 128 + cl), b1 = *(const f32x4*)(lnb + g * 128 + cl + 4);
    { float sm[16], sq[16];
#pragma unroll
      for (int q = 0; q < 16; ++q) { float x[8]; unpack8(raw[q], x); sm[q] = (x[0] + x[1]) + (x[2] + x[3]) + (x[4] + x[5]) + (x[6] + x[7]); }
      wave_sum_n<16>(sm);
#pragma unroll
      for (int q = 0; q < 16; ++q) { float x[8]; unpack8(raw[q], x); const float mean = sm[q] * (1.0f / BW); sm[q] = mean; float q2 = 0.f;
#pragma unroll
          for (int i = 0; i < 8; ++i) { const float d = x[i] - mean; q2 += d * d; }
          sq[q] = q2; }
      wave_sum_n<16>(sq);
      if ((lane >> 4) == g) {
#pragma unroll
          for (int q = 0; q < 16; ++q) { const float mean = sm[q], rstd = rsqrtf(sq[q] * (1.0f / BW) + LN_EPS); float x[8]; unpack8(raw[q], x);
              LAS unsigned* o = (LAS unsigned*)(vimg + (wave * 16 + q) * 260 + cl * 2);
              o[0] = pk2((x[0] - mean) * rstd * g0[0] + b0[0], (x[1] - mean) * rstd * g0[1] + b0[1]); o[1] = pk2((x[2] - mean) * rstd * g0[2] + b0[2], (x[3] - mean) * rstd * g0[3] + b0[3]);
              o[2] = pk2((x[4] - mean) * rstd * g1[0] + b1[0], (x[5] - mean) * rstd * g1[1] + b1[1]); o[3] = pk2((x[6] - mean) * rstd * g1[2] + b1[2], (x[7] - mean) * rstd * g1[3] + b1[3]); } } }
    __syncthreads();
    { bf16x8 Xf[4];
#pragma unroll
      for (int ks = 0; ks < 4; ++ks)
#pragma unroll
          for (int e = 0; e < 8; ++e) Xf[ks][e] = *(const LAS short*)(vimg + (ks * 32 + 8 * fq + e) * 260 + (c0 + fr) * 2);
#pragma unroll
      for (int tb = 0; tb < 8; ++tb) { f32x4 acc = (f32x4){0.f, 0.f, 0.f, 0.f};
#pragma unroll
          for (int ks = 0; ks < 4; ++ks) if (ks <= tb / 2) { const bf16x8 Yf = *(const bf16x8*)(sw + (size_t)(g * 128 + tb * 16 + fr) * 128 + ks * 32 + 8 * fq);
              acc = __builtin_amdgcn_mfma_f32_16x16x32_bf16(Xf[ks], Yf, acc, 0, 0, 0); }
          const int t = tb * 16 + fr;
          v2u o; o.x = pk2(bf_lo(ur[tb].x) * (acc[0] + bsv[tb]), bf_hi(ur[tb].x) * (acc[1] + bsv[tb])); o.y = pk2(bf_lo(ur[tb].y) * (acc[2] + bsv[tb]), bf_hi(ur[tb].y) * (acc[3] + bsv[tb]));
          *(v2u*)(Y + (size_t)(t0 + t) * D + 1024 + g * 128 + c0 + 4 * fq) = o; } }
    __syncthreads();
}
__device__ __forceinline__ void mix_sconv_unit(const bf16* PM, bf16* Y, const float* sw, int t0, int lane, int wave) {
    asm volatile("" : "+v"(lane));
    const int ch = lane * 8, tb = t0 + wave * 8;
    float w0[8], w1[8], w2[8], xm2[8], xm1[8];
#pragma unroll
    for (int i = 0; i < 8; ++i) { w0[i] = sw[ch + i]; w1[i] = sw[BW + ch + i]; w2[i] = sw[2 * BW + ch + i]; xm2[i] = 0.f; xm1[i] = 0.f; }
    if (tb >= 2) { unpack8(*(const v4u*)(PM + (size_t)(tb - 2) * PMW + 2560 + ch), xm2); }
    if (tb >= 1) { unpack8(*(const v4u*)(PM + (size_t)(tb - 1) * PMW + 2560 + ch), xm1); }
#pragma unroll
    for (int i = 0; i < 8; ++i) { const int t = tb + i; float x[8], gb[8], y[8];
        unpack8(*(const v4u*)(PM + (size_t)t * PMW + 2560 + ch), x); unpack8(*(const v4u*)(PM + (size_t)t * PMW + 2048 + ch), gb);
#pragma unroll
        for (int e = 0; e < 8; ++e) { y[e] = gb[e] * (w0[e] * xm2[e] + w1[e] * xm1[e] + w2[e] * x[e]); xm2[e] = xm1[e]; xm1[e] = x[e]; }
        v4u o; o.x = pk2(y[0], y[1]); o.y = pk2(y[2], y[3]); o.z = pk2(y[4], y[5]); o.w = pk2(y[6], y[7]);
        *(v4u*)(Y + (size_t)t * D + 1536 + ch) = o; }
}

__global__ void __launch_bounds__(NTHREADS, 2) fwd_kernel(Args args) {
    extern __shared__ __attribute__((aligned(16))) unsigned char lds_raw[];
    LAS unsigned char* lds = (LAS unsigned char*)lds_raw;
    volatile LAS unsigned* MISC = (volatile LAS unsigned*)(lds + MISC_OFF);
    const int tid = threadIdx.x, lane = tid & 63, wave = __builtin_amdgcn_readfirstlane(tid >> 6);
    const int G = gridDim.x, bx = blockIdx.x, vcu = (G % 8 == 0) ? (bx % 8) * (G / 8) + bx / 8 : bx;
    const int gw = vcu * NWAVES + wave, NGW = G * NWAVES;
    gu32* ctl; int lo, hi; { const KArgs ap = kargs(); ctl = (gu32*)(ap->ws + WS_CTL); lo = ap->ph_lo; hi = ap->ph_hi; }
    for (int u = tid; u < (LDS_BYTES - LDSCTL_OFF) / 4; u += NTHREADS) ((LAS unsigned*)(lds + LDSCTL_OFF))[u] = 0u;
    __syncthreads();
    XcdBarrier bar; bar.bar = (unsigned*)(ctl + CW_BAR); bar.x = 0; bar.st = nullptr;
    if (!MK_PER_PHASE) bar = xcd_barrier_post((unsigned*)(ctl + CW_BAR), MISC + 8);
#define GRID_BAR() do { if (MK_PER_PHASE) { if (tid == 0) __hip_atomic_store(ctl + CW_TMO, 0xBADBA0u, RLX_AGENT); } else { XcdBarrier b2_ = bar; asm volatile("" : "+s"(b2_.bar), "+s"(b2_.x)); xcd_barrier(b2_); } } while (0)
#ifndef PH_MASK
#define PH_MASK 0xff
#endif
#define PHEN(t) (((PH_MASK) >> (t)) & 1)
#ifndef REP_MASK
#define REP_MASK 0
#endif
#define NREP(t) (1 + (((REP_MASK) >> (t)) & 1))
#ifndef MIX_MASK
#define MIX_MASK 0xf
#endif
#define MIXEN(t) (((MIX_MASK) >> (t)) & 1)
#define IN(k) (lo <= (k) && (k) < hi)
#ifndef BAR_REP
#define BAR_REP 1
#endif
#define SEAM(k) do { if (IN((k) + 1)) { for (int br_ = 0; br_ < BAR_REP; ++br_) GRID_BAR(); } } while (0)

    if (PHEN(0) && IN(0)) {
        const KArgs ap = kargs();
        LAS unsigned* scr = (LAS unsigned*)(lds + RING_OFF + wave * 8448);
        for (int rep = 0; rep < NREP(0); ++rep) {
            { int nd = 0; for (int it = gw; it < N_ADA_ITEMS; it += NGW) { p0_ada_item(ap, it, lane); ++nd; }
              asm volatile("s_waitcnt vmcnt(0)" ::: "memory");
              if (lane == 0 && nd) __hip_atomic_fetch_add(ctl + CW_ADA, (unsigned)nd, RLX_AGENT); }
            constexpr int NCONV = NL * CONV_ITEMS_PER_LAYER;
            const int nA = (N_ADA_ITEMS > NGW ? N_ADA_ITEMS - NGW : 0) / NWAVES, limA = nA * NWAVES * P0_A_STEPS;
            const bool clsA = vcu < nA;
            int ci = clsA ? vcu * NWAVES + wave : limA + (vcu - nA) * NWAVES + wave;
            const int cstride = clsA ? nA * NWAVES : (G - nA) * NWAVES, climit = clsA ? limA : NCONV;
            if (ci < climit) {
                TrJob cur = p0_conv_job(ap, ci); f32x4 v[8][2]; tr_load(cur, v, lane);
                for (;;) {
                    const int cn = ci + cstride; const bool has = cn < climit; TrJob nx = cur; f32x4 w[8][2];
                    if (has) { nx = p0_conv_job(ap, cn); tr_load(nx, w, lane); }
                    tr_finish(cur, v, scr, lane);
                    if (!has) break;
                    cur = nx; ci = cn;
#pragma unroll
                    for (int jp = 0; jp < 8; ++jp) { v[jp][0] = w[jp][0]; v[jp][1] = w[jp][1]; }
                }
            }
            for (int it = gw; it < N_SGU_ITEMS; it += NGW) p0_sgu_item(ap, it, lane);
        }
    }
    if (PHEN(1) && IN(1)) {
        const KArgs ap = kargs(); unsigned char* ws = ap->ws; const float* x_in = ap->in[0]; float* xres = ap->out; const float* adap = (const float*)(ws + WS_ADAP); const float* ada_b = ap->in[3];
        bf16* NBUF = (bf16*)(ws + WS_NBUF); bf16* ACT = (bf16*)(ws + WS_ACT); bf16* Z = (bf16*)(ws + WS_Z); bf16* PM = (bf16*)(ws + WS_PM); bf16* GB = (bf16*)(ws + WS_G); bf16* YB = (bf16*)(ws + WS_Y); bf16* MG = (bf16*)(ws + WS_MG); bf16* XB = (bf16*)(ws + WS_XB); (void)XB;
        (void)x_in; (void)xres; (void)adap; (void)ada_b; (void)NBUF; (void)ACT; (void)Z; (void)PM; (void)GB; (void)YB; (void)MG;
        if (!MK_PER_PHASE) {
            if (tid == 0) { unsigned sp_ = 0; while (__hip_atomic_load(ctl + CW_ADA, RLX_AGENT) < (unsigned)N_ADA_ITEMS) { __builtin_amdgcn_s_sleep(2); if (++sp_ > (1u << 22)) { __hip_atomic_store(ctl + CW_TMO, 0xADA0u, RLX_AGENT); break; } }
                __builtin_amdgcn_fence(__ATOMIC_ACQUIRE, "agent"); asm volatile("s_waitcnt vmcnt(0)" ::: "memory"); }
            __syncthreads(); }
        resnorm_phase<false, true, true, false>(lds, x_in, nullptr, nullptr, NBUF, adap, ada_b, nullptr, 0, 0.f, ap->in[4], 0, gw, NGW, tid, lane);
        SEAM(1);
    }
    for (int l = 0; l < NL; ++l) {
        const int pb = 2 + 11 * l;
        if (PHEN(2) && IN(pb + 0)) {
            const KArgs ap = kargs(); unsigned char* ws = ap->ws; const float* x_in = ap->in[0]; float* xres = ap->out; const float* adap = (const float*)(ws + WS_ADAP); const float* ada_b = ap->in[3];
            bf16* NBUF = (bf16*)(ws + WS_NBUF); bf16* ACT = (bf16*)(ws + WS_ACT); bf16* Z = (bf16*)(ws + WS_Z); bf16* PM = (bf16*)(ws + WS_PM); bf16* GB = (bf16*)(ws + WS_G); bf16* YB = (bf16*)(ws + WS_Y); bf16* MG = (bf16*)(ws + WS_MG); bf16* XB = (bf16*)(ws + WS_XB); (void)XB;
            (void)x_in; (void)xres; (void)adap; (void)ada_b; (void)NBUF; (void)ACT; (void)Z; (void)PM; (void)GB; (void)YB; (void)MG;
            int lp = l; asm volatile("" : "+s"(lp));
            const bf16* WIN0 = (const bf16*)(ws + WS_WIN) + (size_t)(lp * 2) * 2 * FF * D; const bf16* WOUT0 = (const bf16*)(ws + WS_WOUT) + (size_t)(lp * 2) * D * FF;
            const bf16* WMIX = (const bf16*)(ws + WS_WMIX) + (size_t)lp * NMIXG * D; const bf16* WBR = (const bf16*)(ws + WS_WBR) + (size_t)lp * D * 2048; const bf16* WO = (const bf16*)(ws + WS_WO) + (size_t)lp * D * D;
            (void)WIN0; (void)WOUT0; (void)WMIX; (void)WBR; (void)WO;
            pg8::Gemm g{NBUF, WIN0, S, 2 * FF, D}; pg8::StaticOrder So; So.init(S, 2 * FF, G, bx);
            pg8::EpiSwiGLU E{ACT, FF};
            for (int rep = 0; rep < NREP(2); ++rep) pg8::gemm_phase<pg8::EpiSwiGLU, pg8::StaticOrder, PG8_ALIGN, PG8_SP2>(lds + RING_OFF, g, So, E);
            SEAM(pb + 0);
        }
        if (PHEN(3) && IN(pb + 1)) {
            const KArgs ap = kargs(); unsigned char* ws = ap->ws; const float* x_in = ap->in[0]; float* xres = ap->out; const float* adap = (const float*)(ws + WS_ADAP); const float* ada_b = ap->in[3];
            bf16* NBUF = (bf16*)(ws + WS_NBUF); bf16* ACT = (bf16*)(ws + WS_ACT); bf16* Z = (bf16*)(ws + WS_Z); bf16* PM = (bf16*)(ws + WS_PM); bf16* GB = (bf16*)(ws + WS_G); bf16* YB = (bf16*)(ws + WS_Y); bf16* MG = (bf16*)(ws + WS_MG); bf16* XB = (bf16*)(ws + WS_XB); (void)XB;
            (void)x_in; (void)xres; (void)adap; (void)ada_b; (void)NBUF; (void)ACT; (void)Z; (void)PM; (void)GB; (void)YB; (void)MG;
            int lp = l; asm volatile("" : "+s"(lp));
            const bf16* WIN0 = (const bf16*)(ws + WS_WIN) + (size_t)(lp * 2) * 2 * FF * D; const bf16* WOUT0 = (const bf16*)(ws + WS_WOUT) + (size_t)(lp * 2) * D * FF;
            const bf16* WMIX = (const bf16*)(ws + WS_WMIX) + (size_t)lp * NMIXG * D; const bf16* WBR = (const bf16*)(ws + WS_WBR) + (size_t)lp * D * 2048; const bf16* WO = (const bf16*)(ws + WS_WO) + (size_t)lp * D * D;
            (void)WIN0; (void)WOUT0; (void)WMIX; (void)WBR; (void)WO;
            pg8::Gemm g{ACT, WOUT0, S, D, FF}; pg8::StaticOrder So; So.init(S, D, G, bx);
            pg8::EpiBf16Plain E{Z, D};
            for (int rep = 0; rep < NREP(3); ++rep) pg8::gemm_phase<pg8::EpiBf16Plain, pg8::StaticOrder, PG8_ALIGN, PG8_SP2>(lds + RING_OFF, g, So, E);
            SEAM(pb + 1);
        }
        if (PHEN(1) && IN(pb + 2)) {
            const KArgs ap = kargs(); unsigned char* ws = ap->ws; const float* x_in = ap->in[0]; float* xres = ap->out; const float* adap = (const float*)(ws + WS_ADAP); const float* ada_b = ap->in[3];
            bf16* NBUF = (bf16*)(ws + WS_NBUF); bf16* ACT = (bf16*)(ws + WS_ACT); bf16* Z = (bf16*)(ws + WS_Z); bf16* PM = (bf16*)(ws + WS_PM); bf16* GB = (bf16*)(ws + WS_G); bf16* YB = (bf16*)(ws + WS_Y); bf16* MG = (bf16*)(ws + WS_MG); bf16* XB = (bf16*)(ws + WS_XB); (void)XB;
            (void)x_in; (void)xres; (void)adap; (void)ada_b; (void)NBUF; (void)ACT; (void)Z; (void)PM; (void)GB; (void)YB; (void)MG;
            int lp = l; asm volatile("" : "+s"(lp));
            const bf16* WIN0 = (const bf16*)(ws + WS_WIN) + (size_t)(lp * 2) * 2 * FF * D; const bf16* WOUT0 = (const bf16*)(ws + WS_WOUT) + (size_t)(lp * 2) * D * FF;
            const bf16* WMIX = (const bf16*)(ws + WS_WMIX) + (size_t)lp * NMIXG * D; const bf16* WBR = (const bf16*)(ws + WS_WBR) + (size_t)lp * D * 2048; const bf16* WO = (const bf16*)(ws + WS_WO) + (size_t)lp * D * D;
            (void)WIN0; (void)WOUT0; (void)WMIX; (void)WBR; (void)WO;
            if (lp == 0) resnorm_phase<true, true, true, false>(lds, x_in, XB, Z, NBUF, adap, ada_b, ap->in[5] + (size_t)(lp * 3 + 0) * D, lp * NADA + (0 * 3 + 2) * D, 0.5f,
                                      ap->in[4] + (size_t)(lp * 3 + 1) * D, lp * NADA + (1 * 3) * D, gw, NGW, tid, lane);
            else resnorm_phase<true, true, false, false>(lds, XB, XB, Z, NBUF, adap, ada_b, ap->in[5] + (size_t)(lp * 3 + 0) * D, lp * NADA + (0 * 3 + 2) * D, 0.5f,
                                      ap->in[4] + (size_t)(lp * 3 + 1) * D, lp * NADA + (1 * 3) * D, gw, NGW, tid, lane);
            SEAM(pb + 2);
        }
        if (PHEN(4) && IN(pb + 3)) {
            const KArgs ap = kargs(); unsigned char* ws = ap->ws; const float* x_in = ap->in[0]; float* xres = ap->out; const float* adap = (const float*)(ws + WS_ADAP); const float* ada_b = ap->in[3];
            bf16* NBUF = (bf16*)(ws + WS_NBUF); bf16* ACT = (bf16*)(ws + WS_ACT); bf16* Z = (bf16*)(ws + WS_Z); bf16* PM = (bf16*)(ws + WS_PM); bf16* GB = (bf16*)(ws + WS_G); bf16* YB = (bf16*)(ws + WS_Y); bf16* MG = (bf16*)(ws + WS_MG); bf16* XB = (bf16*)(ws + WS_XB); (void)XB;
            (void)x_in; (void)xres; (void)adap; (void)ada_b; (void)NBUF; (void)ACT; (void)Z; (void)PM; (void)GB; (void)YB; (void)MG;
            int lp = l; asm volatile("" : "+s"(lp));
            const bf16* WIN0 = (const bf16*)(ws + WS_WIN) + (size_t)(lp * 2) * 2 * FF * D; const bf16* WOUT0 = (const bf16*)(ws + WS_WOUT) + (size_t)(lp * 2) * D * FF;
            const bf16* WMIX = (const bf16*)(ws + WS_WMIX) + (size_t)lp * NMIXG * D; const bf16* WBR = (const bf16*)(ws + WS_WBR) + (size_t)lp * D * 2048; const bf16* WO = (const bf16*)(ws + WS_WO) + (size_t)lp * D * D;
            (void)WIN0; (void)WOUT0; (void)WMIX; (void)WBR; (void)WO;
            pg8::Gemm g{NBUF, WMIX, S, 4096, D}; pg8::StaticOrder So; So.init(S, 4096, G, bx);
            pg8::EpiMix E{PM, GB, ap->in[10] + (size_t)lp * 4 * D, 0};
            for (int rep = 0; rep < NREP(4); ++rep) pg8::gemm_phase<pg8::EpiMix, pg8::StaticOrder, PG8_ALIGN, PG8_SP2>(lds + RING_OFF, g, So, E);
            SEAM(pb + 3);
        }
        if (PHEN(5) && IN(pb + 4)) {
            const KArgs ap = kargs(); unsigned char* ws = ap->ws; const float* x_in = ap->in[0]; float* xres = ap->out; const float* adap = (const float*)(ws + WS_ADAP); const float* ada_b = ap->in[3];
            bf16* NBUF = (bf16*)(ws + WS_NBUF); bf16* ACT = (bf16*)(ws + WS_ACT); bf16* Z = (bf16*)(ws + WS_Z); bf16* PM = (bf16*)(ws + WS_PM); bf16* GB = (bf16*)(ws + WS_G); bf16* YB = (bf16*)(ws + WS_Y); bf16* MG = (bf16*)(ws + WS_MG); bf16* XB = (bf16*)(ws + WS_XB); (void)XB;
            (void)x_in; (void)xres; (void)adap; (void)ada_b; (void)NBUF; (void)ACT; (void)Z; (void)PM; (void)GB; (void)YB; (void)MG;
            int lp = l; asm volatile("" : "+s"(lp));
            const bf16* WIN0 = (const bf16*)(ws + WS_WIN) + (size_t)(lp * 2) * 2 * FF * D; const bf16* WOUT0 = (const bf16*)(ws + WS_WOUT) + (size_t)(lp * 2) * D * FF;
            const bf16* WMIX = (const bf16*)(ws + WS_WMIX) + (size_t)lp * NMIXG * D; const bf16* WBR = (const bf16*)(ws + WS_WBR) + (size_t)lp * D * 2048; const bf16* WO = (const bf16*)(ws + WS_WO) + (size_t)lp * D * D;
            (void)WIN0; (void)WOUT0; (void)WMIX; (void)WBR; (void)WO;
            {
            int wv = wave, vc = vcu; asm volatile("" : "+s"(wv), "+s"(vc));
            if (MIXEN(0)) for (int i = 0; i < 2 * NREP(5); ++i) { const int u = vc + G * (i & 1); if (u < S / 32)
                mix_conv_unit(lds, PM, YB, ap->in[11] + (size_t)lp * 31 * BW, ap->in[12] + (size_t)lp * BW, ap->in[13] + (size_t)lp * BW, ap->in[14] + (size_t)lp * BW, 32 * u, tid, lane, wv); }
            if (MIXEN(1)) for (int i = 0; i < 2 * NREP(5); ++i) { const int u = vc + G * (i & 1); if (u < S / 32)
                mix_pool_unit(lds, PM, YB, (const bf16*)(ws + WS_POOLW) + (size_t)lp * 4 * 128 * 128, ap->in[16] + (size_t)lp * BW, 32 * u, tid, lane, wv); }
            if (MIXEN(2)) for (int i = 0; i < 2 * NREP(5); ++i) { const int u = vc + G * (i & 1); if (u < (S / 128) * 4)
                mix_sgu_unit(lds, PM, YB, (const bf16*)(ws + WS_SGUW) + (size_t)lp * 4 * 128 * 128, ap->in[17] + (size_t)lp * BW, ap->in[18] + (size_t)lp * BW, ap->in[20] + (size_t)lp * 4 * 128, u >> 2, u & 3, tid, lane, wv); }
            if (MIXEN(3)) for (int i = 0; i < NREP(5); ++i) { const int u = vc; if (u < S / 64) mix_sconv_unit(PM, YB, ap->in[21] + (size_t)lp * 3 * BW, 64 * u, lane, wv); }
            }
            __syncthreads();
            { pg8::Gemm g{NBUF, WMIX + (size_t)4096 * D, S, 8192, D}; pg8::StaticOrder So; So.init(S, 8192, G, bx);
              pg8::EpiMix E{PM, GB, ap->in[10] + (size_t)lp * 4 * D, 16};
              pg8::gemm_phase<pg8::EpiMix, pg8::StaticOrder, PG8_ALIGN, PG8_SP2>(lds + RING_OFF, g, So, E); }
            SEAM(pb + 4);
        }
        if (PHEN(6) && IN(pb + 5)) {
            const KArgs ap = kargs(); unsigned char* ws = ap->ws; const float* x_in = ap->in[0]; float* xres = ap->out; const float* adap = (const float*)(ws + WS_ADAP); const float* ada_b = ap->in[3];
            bf16* NBUF = (bf16*)(ws + WS_NBUF); bf16* ACT = (bf16*)(ws + WS_ACT); bf16* Z = (bf16*)(ws + WS_Z); bf16* PM = (bf16*)(ws + WS_PM); bf16* GB = (bf16*)(ws + WS_G); bf16* YB = (bf16*)(ws + WS_Y); bf16* MG = (bf16*)(ws + WS_MG); bf16* XB = (bf16*)(ws + WS_XB); (void)XB;
            (void)x_in; (void)xres; (void)adap; (void)ada_b; (void)NBUF; (void)ACT; (void)Z; (void)PM; (void)GB; (void)YB; (void)MG;
            int lp = l; asm volatile("" : "+s"(lp));
            const bf16* WIN0 = (const bf16*)(ws + WS_WIN) + (size_t)(lp * 2) * 2 * FF * D; const bf16* WOUT0 = (const bf16*)(ws + WS_WOUT) + (size_t)(lp * 2) * D * FF;
            const bf16* WMIX = (const bf16*)(ws + WS_WMIX) + (size_t)lp * NMIXG * D; const bf16* WBR = (const bf16*)(ws + WS_WBR) + (size_t)lp * D * 2048; const bf16* WO = (const bf16*)(ws + WS_WO) + (size_t)lp * D * D;
            (void)WIN0; (void)WOUT0; (void)WMIX; (void)WBR; (void)WO;
            pg8::StaticOrder So; So.init(S, D, G, bx, 256, 128);
            for (int rep = 0; rep < NREP(6); ++rep) pg8::gated_merge3_phase<pg8::StaticOrder>(lds + RING_OFF, YB, WBR, GB, MG, So);
            SEAM(pb + 5);
        }
        if (PHEN(3) && IN(pb + 6)) {
            const KArgs ap = kargs(); unsigned char* ws = ap->ws; const float* x_in = ap->in[0]; float* xres = ap->out; const float* adap = (const float*)(ws + WS_ADAP); const float* ada_b = ap->in[3];
            bf16* NBUF = (bf16*)(ws + WS_NBUF); bf16* ACT = (bf16*)(ws + WS_ACT); bf16* Z = (bf16*)(ws + WS_Z); bf16* PM = (bf16*)(ws + WS_PM); bf16* GB = (bf16*)(ws + WS_G); bf16* YB = (bf16*)(ws + WS_Y); bf16* MG = (bf16*)(ws + WS_MG); bf16* XB = (bf16*)(ws + WS_XB); (void)XB;
            (void)x_in; (void)xres; (void)adap; (void)ada_b; (void)NBUF; (void)ACT; (void)Z; (void)PM; (void)GB; (void)YB; (void)MG;
            int lp = l; asm volatile("" : "+s"(lp));
            const bf16* WIN0 = (const bf16*)(ws + WS_WIN) + (size_t)(lp * 2) * 2 * FF * D; const bf16* WOUT0 = (const bf16*)(ws + WS_WOUT) + (size_t)(lp * 2) * D * FF;
            const bf16* WMIX = (const bf16*)(ws + WS_WMIX) + (size_t)lp * NMIXG * D; const bf16* WBR = (const bf16*)(ws + WS_WBR) + (size_t)lp * D * 2048; const bf16* WO = (const bf16*)(ws + WS_WO) + (size_t)lp * D * D;
            (void)WIN0; (void)WOUT0; (void)WMIX; (void)WBR; (void)WO;
            pg8::Gemm g{MG, WO, S, D, D}; pg8::StaticOrder So; So.init(S, D, G, bx);
            pg8::EpiBf16Plain E{Z, D};
            for (int rep = 0; rep < NREP(7); ++rep) pg8::gemm_phase<pg8::EpiBf16Plain, pg8::StaticOrder, PG8_ALIGN, PG8_SP2>(lds + RING_OFF, g, So, E);
            SEAM(pb + 6);
        }
        if (PHEN(1) && IN(pb + 7)) {
            const KArgs ap = kargs(); unsigned char* ws = ap->ws; const float* x_in = ap->in[0]; float* xres = ap->out; const float* adap = (const float*)(ws + WS_ADAP); const float* ada_b = ap->in[3];
            bf16* NBUF = (bf16*)(ws + WS_NBUF); bf16* ACT = (bf16*)(ws + WS_ACT); bf16* Z = (bf16*)(ws + WS_Z); bf16* PM = (bf16*)(ws + WS_PM); bf16* GB = (bf16*)(ws + WS_G); bf16* YB = (bf16*)(ws + WS_Y); bf16* MG = (bf16*)(ws + WS_MG); bf16* XB = (bf16*)(ws + WS_XB); (void)XB;
            (void)x_in; (void)xres; (void)adap; (void)ada_b; (void)NBUF; (void)ACT; (void)Z; (void)PM; (void)GB; (void)YB; (void)MG;
            int lp = l; asm volatile("" : "+s"(lp));
            const bf16* WIN0 = (const bf16*)(ws + WS_WIN) + (size_t)(lp * 2) * 2 * FF * D; const bf16* WOUT0 = (const bf16*)(ws + WS_WOUT) + (size_t)(lp * 2) * D * FF;
            const bf16* WMIX = (const bf16*)(ws + WS_WMIX) + (size_t)lp * NMIXG * D; const bf16* WBR = (const bf16*)(ws + WS_WBR) + (size_t)lp * D * 2048; const bf16* WO = (const bf16*)(ws + WS_WO) + (size_t)lp * D * D;
            (void)WIN0; (void)WOUT0; (void)WMIX; (void)WBR; (void)WO;
            resnorm_phase<true, true, false, false>(lds, XB, XB, Z, NBUF, adap, ada_b, ap->in[5] + (size_t)(lp * 3 + 1) * D, lp * NADA + (1 * 3 + 2) * D, 1.0f,
                                      ap->in[4] + (size_t)(lp * 3 + 2) * D, lp * NADA + (2 * 3) * D, gw, NGW, tid, lane);
            SEAM(pb + 7);
        }
        if (PHEN(2) && IN(pb + 8)) {
            const KArgs ap = kargs(); unsigned char* ws = ap->ws; const float* x_in = ap->in[0]; float* xres = ap->out; const float* adap = (const float*)(ws + WS_ADAP); const float* ada_b = ap->in[3];
            bf16* NBUF = (bf16*)(ws + WS_NBUF); bf16* ACT = (bf16*)(ws + WS_ACT); bf16* Z = (bf16*)(ws + WS_Z); bf16* PM = (bf16*)(ws + WS_PM); bf16* GB = (bf16*)(ws + WS_G); bf16* YB = (bf16*)(ws + WS_Y); bf16* MG = (bf16*)(ws + WS_MG); bf16* XB = (bf16*)(ws + WS_XB); (void)XB;
            (void)x_in; (void)xres; (void)adap; (void)ada_b; (void)NBUF; (void)ACT; (void)Z; (void)PM; (void)GB; (void)YB; (void)MG;
            int lp = l; asm volatile("" : "+s"(lp));
            const bf16* WIN0 = (const bf16*)(ws + WS_WIN) + (size_t)(lp * 2) * 2 * FF * D; const bf16* WOUT0 = (const bf16*)(ws + WS_WOUT) + (size_t)(lp * 2) * D * FF;
            const bf16* WMIX = (const bf16*)(ws + WS_WMIX) + (size_t)lp * NMIXG * D; const bf16* WBR = (const bf16*)(ws + WS_WBR) + (size_t)lp * D * 2048; const bf16* WO = (const bf16*)(ws + WS_WO) + (size_t)lp * D * D;
            (void)WIN0; (void)WOUT0; (void)WMIX; (void)WBR; (void)WO;
            pg8::Gemm g{NBUF, WIN0 + (size_t)2 * FF * D, S, 2 * FF, D}; pg8::StaticOrder So; So.init(S, 2 * FF, G, bx);
            pg8::EpiSwiGLU E{ACT, FF};
            for (int rep = 0; rep < NREP(2); ++rep) pg8::gemm_phase<pg8::EpiSwiGLU, pg8::StaticOrder, PG8_ALIGN, PG8_SP2>(lds + RING_OFF, g, So, E);
            SEAM(pb + 8);
        }
        if (PHEN(3) && IN(pb + 9)) {
            const KArgs ap = kargs(); unsigned char* ws = ap->ws; const float* x_in = ap->in[0]; float* xres = ap->out; const float* adap = (const float*)(ws + WS_ADAP); const float* ada_b = ap->in[3];
            bf16* NBUF = (bf16*)(ws + WS_NBUF); bf16* ACT = (bf16*)(ws + WS_ACT); bf16* Z = (bf16*)(ws + WS_Z); bf16* PM = (bf16*)(ws + WS_PM); bf16* GB = (bf16*)(ws + WS_G); bf16* YB = (bf16*)(ws + WS_Y); bf16* MG = (bf16*)(ws + WS_MG); bf16* XB = (bf16*)(ws + WS_XB); (void)XB;
            (void)x_in; (void)xres; (void)adap; (void)ada_b; (void)NBUF; (void)ACT; (void)Z; (void)PM; (void)GB; (void)YB; (void)MG;
            int lp = l; asm volatile("" : "+s"(lp));
            const bf16* WIN0 = (const bf16*)(ws + WS_WIN) + (size_t)(lp * 2) * 2 * FF * D; const bf16* WOUT0 = (const bf16*)(ws + WS_WOUT) + (size_t)(lp * 2) * D * FF;
            const bf16* WMIX = (const bf16*)(ws + WS_WMIX) + (size_t)lp * NMIXG * D; const bf16* WBR = (const bf16*)(ws + WS_WBR) + (size_t)lp * D * 2048; const bf16* WO = (const bf16*)(ws + WS_WO) + (size_t)lp * D * D;
            (void)WIN0; (void)WOUT0; (void)WMIX; (void)WBR; (void)WO;
            pg8::Gemm g{ACT, WOUT0 + (size_t)D * FF, S, D, FF}; pg8::StaticOrder So; So.init(S, D, G, bx);
            pg8::EpiBf16Plain E{Z, D};
            for (int rep = 0; rep < NREP(3); ++rep) pg8::gemm_phase<pg8::EpiBf16Plain, pg8::StaticOrder, PG8_ALIGN, PG8_SP2>(lds + RING_OFF, g, So, E);
            SEAM(pb + 9);
        }
        if (PHEN(1) && IN(pb + 10)) {
            const KArgs ap = kargs(); unsigned char* ws = ap->ws; const float* x_in = ap->in[0]; float* xres = ap->out; const float* adap = (const float*)(ws + WS_ADAP); const float* ada_b = ap->in[3];
            bf16* NBUF = (bf16*)(ws + WS_NBUF); bf16* ACT = (bf16*)(ws + WS_ACT); bf16* Z = (bf16*)(ws + WS_Z); bf16* PM = (bf16*)(ws + WS_PM); bf16* GB = (bf16*)(ws + WS_G); bf16* YB = (bf16*)(ws + WS_Y); bf16* MG = (bf16*)(ws + WS_MG); bf16* XB = (bf16*)(ws + WS_XB); (void)XB;
            (void)x_in; (void)xres; (void)adap; (void)ada_b; (void)NBUF; (void)ACT; (void)Z; (void)PM; (void)GB; (void)YB; (void)MG;
            int lp = l; asm volatile("" : "+s"(lp));
            const bf16* WIN0 = (const bf16*)(ws + WS_WIN) + (size_t)(lp * 2) * 2 * FF * D; const bf16* WOUT0 = (const bf16*)(ws + WS_WOUT) + (size_t)(lp * 2) * D * FF;
            const bf16* WMIX = (const bf16*)(ws + WS_WMIX) + (size_t)lp * NMIXG * D; const bf16* WBR = (const bf16*)(ws + WS_WBR) + (size_t)lp * D * 2048; const bf16* WO = (const bf16*)(ws + WS_WO) + (size_t)lp * D * D;
            (void)WIN0; (void)WOUT0; (void)WMIX; (void)WBR; (void)WO;
            if (lp + 1 < NL)
                resnorm_phase<true, true, false, false>(lds, XB, XB, Z, NBUF, adap, ada_b, ap->in[5] + (size_t)(lp * 3 + 2) * D, lp * NADA + (2 * 3 + 2) * D, 0.5f,
                                          ap->in[4] + (size_t)((lp + 1) * 3 + 0) * D, (lp + 1) * NADA, gw, NGW, tid, lane);
            else
                resnorm_phase<true, false, false, true>(lds, XB, xres, Z, NBUF, adap, ada_b, ap->in[5] + (size_t)(lp * 3 + 2) * D, lp * NADA + (2 * 3 + 2) * D, 0.5f,
                                           nullptr, 0, gw, NGW, tid, lane);
            SEAM(pb + 10);
        }
    }
#undef IN
#undef SEAM
#undef GRID_BAR
}


extern "C" void kernel_launch(void* const* d_in, const int* in_sizes, int n_in, void* d_out, int out_size, void* d_ws, size_t ws_size, hipStream_t stream) {
    static int grid = 0;
    if (grid == 0) {
        if (n_in != 24 || in_sizes[0] != S * D || out_size != S * D || ws_size < WS_END) { fprintf(stderr, "kernel_launch: unexpected shapes (n_in %d, in0 %d, out %d, ws %zu < %zu); nothing launched\n", n_in, n_in > 0 ? in_sizes[0] : -1, out_size, ws_size, (size_t)WS_END); grid = -1; return; }
        int dev = 0, cus = 0, per_cu = 0;
        if (hipGetDevice(&dev) != hipSuccess || hipDeviceGetAttribute(&cus, hipDeviceAttributeMultiprocessorCount, dev) != hipSuccess) { fprintf(stderr, "kernel_launch: device query failed\n"); grid = -1; return; }
        if (hipFuncSetAttribute((const void*)fwd_kernel, hipFuncAttributeMaxDynamicSharedMemorySize, LDS_BYTES) != hipSuccess) { fprintf(stderr, "kernel_launch: hipFuncSetAttribute failed\n"); grid = -1; return; }
        if (hipOccupancyMaxActiveBlocksPerMultiprocessor(&per_cu, (const void*)fwd_kernel, NTHREADS, LDS_BYTES) != hipSuccess || per_cu < 1) { fprintf(stderr, "kernel_launch: occupancy query reports %d workgroups per CU\n", per_cu); per_cu = 1; }
        (void)hipGetLastError();
        grid = cus;
        if (grid % 8 != 0 || grid <= 0) { fprintf(stderr, "kernel_launch: unexpected CU count %d\n", cus); }
    }
    if (grid < 0) return;
    if (hipMemsetAsync((char*)d_ws + WS_CTL, 0, CTL_ZERO_BYTES, stream) != hipSuccess) { fprintf(stderr, "kernel_launch: memset failed\n"); return; }
    Args a{};
    for (int i = 0; i < 24; ++i) a.in[i] = (const float*)d_in[i];
    a.out = (float*)d_out; a.ws = (unsigned char*)d_ws;
#if MK_PER_PHASE
    for (int ph = 0; ph < NPHASES; ++ph) { a.ph_lo = ph; a.ph_hi = ph + 1; hipLaunchKernelGGL(fwd_kernel, dim3(grid), dim3(NTHREADS), LDS_BYTES, stream, a); }
#else
    a.ph_lo = 0; a.ph_hi = NPHASES;
    hipLaunchKernelGGL(fwd_kernel, dim3(grid), dim3(NTHREADS), LDS_BYTES, stream, a);
#endif
    const hipError_t le = hipPeekAtLastError();
    if (le != hipSuccess) fprintf(stderr, "kernel_launch: launch failed: %s\n", hipGetErrorName(le));
}
```
